# Optimizing an MI355X kernel written in HIP

```python
import math
import jax, jax.numpy as jnp
from jax import lax
import numpy as np

D_MODEL = 1024
BATCH = 32
SEQ = 2048
DEPTH = 1

ATTN_HEADS = 8
HEAD_DIM = 64
ATTN_WIDTH = ATTN_HEADS * HEAD_DIM
LRU_WIDTH = D_MODEL - ATTN_WIDTH
LRU_BLOCKS = 8
LRU_BLOCK_DIM = LRU_WIDTH // LRU_BLOCKS
MIX_WIDTH = ATTN_WIDTH + LRU_WIDTH
IN_WIDTH = 4 * ATTN_WIDTH + 2 * LRU_WIDTH
MOBA_BLOCK = 256
MOBA_TOPK = 3
QUERY_CHUNK = 8
CONV_WIDTH = 4
LRU_C = 8.0
ROPE_THETA = 10000.0
EPS = 1e-6

kernel_name = "hymba_moba_rglru_block"


def rmsnorm(x, gain):
    xf = x.astype(jnp.float32)
    y = xf * lax.rsqrt(jnp.mean(xf * xf, axis=-1, keepdims=True) + EPS)
    return (y * gain.astype(jnp.float32)).astype(x.dtype)


def rope_tables(seq_len):
    pos = jnp.arange(seq_len, dtype=jnp.float32)
    inv_freq = ROPE_THETA ** (-jnp.arange(0, HEAD_DIM, 2, dtype=jnp.float32) / HEAD_DIM)
    ang = pos[:, None] * inv_freq[None, :]
    return jnp.cos(ang), jnp.sin(ang)


def apply_rope(t, cos, sin):
    tf = t.astype(jnp.float32)
    t1, t2 = tf[..., : HEAD_DIM // 2], tf[..., HEAD_DIM // 2:]
    c, s = cos[None, :, None, :], sin[None, :, None, :]
    return jnp.concatenate([t1 * c - t2 * s, t2 * c + t1 * s], axis=-1).astype(t.dtype)


def moba_attention(q, k, v):
    B, S, H, Dh = q.shape
    n_blk = -(-S // MOBA_BLOCK)
    s_pad = n_blk * MOBA_BLOCK
    pad = ((0, 0), (0, s_pad - S), (0, 0), (0, 0))
    q, k, v = [jnp.pad(t, pad).transpose(0, 2, 1, 3) for t in (q, k, v)]
    k_blk = k.reshape(B, H, n_blk, MOBA_BLOCK, Dh)
    v_blk = v.reshape(B, H, n_blk, MOBA_BLOCK, Dh)
    k_mean = jnp.mean(k_blk.astype(jnp.float32), axis=3).astype(q.dtype)

    q_blk_id = jnp.arange(s_pad) // MOBA_BLOCK
    gate = jnp.einsum('bhsd,bhnd->bhsn', q, k_mean).astype(jnp.float32)
    fully_past = jnp.arange(n_blk)[None, :] < q_blk_id[:, None]
    gate = jnp.where(fully_past, gate, -jnp.inf)
    k_eff = min(MOBA_TOPK, n_blk)
    _, sel_idx = lax.top_k(gate, k_eff)
    n_valid = jnp.minimum(q_blk_id, k_eff)
    sel_valid = jnp.arange(k_eff)[None, :] < n_valid[:, None]

    scale = Dh ** -0.5
    gather_blocks = jax.vmap(jax.vmap(lambda blocks, idx: blocks[idx]))

    def attend_chunk(ci):
        start = ci * QUERY_CHUNK
        q_c = lax.dynamic_slice_in_dim(q, start, QUERY_CHUNK, axis=2)
        idx_c = lax.dynamic_slice_in_dim(sel_idx, start, QUERY_CHUNK, axis=2)
        valid_c = lax.dynamic_slice_in_dim(sel_valid, start, QUERY_CHUNK, axis=0)
        blk_start = (start // MOBA_BLOCK) * MOBA_BLOCK
        k_own = lax.dynamic_slice_in_dim(k, blk_start, MOBA_BLOCK, axis=2)
        v_own = lax.dynamic_slice_in_dim(v, blk_start, MOBA_BLOCK, axis=2)
        qpos = start + jnp.arange(QUERY_CHUNK)
        kpos = blk_start + jnp.arange(MOBA_BLOCK)
        s_own = jnp.einsum('bhqd,bhkd->bhqk', q_c, k_own).astype(jnp.float32) * scale
        s_own = jnp.where(kpos[None, :] <= qpos[:, None], s_own, -jnp.inf)
        k_g = gather_blocks(k_blk, idx_c)
        v_g = gather_blocks(v_blk, idx_c)
        s_sel = jnp.einsum('bhqd,bhqjkd->bhqjk', q_c, k_g).astype(jnp.float32) * scale
        s_sel = jnp.where(valid_c[:, :, None], s_sel, -jnp.inf)
        s_sel = s_sel.reshape(B, H, QUERY_CHUNK, k_eff * MOBA_BLOCK)
        p = jax.nn.softmax(jnp.concatenate([s_own, s_sel], axis=-1), axis=-1).astype(v.dtype)
        p_own = p[..., :MOBA_BLOCK]
        p_sel = p[..., MOBA_BLOCK:].reshape(B, H, QUERY_CHUNK, k_eff, MOBA_BLOCK)
        return (jnp.einsum('bhqk,bhkd->bhqd', p_own, v_own)
                + jnp.einsum('bhqjk,bhqjkd->bhqd', p_sel, v_g))

    n_chunks = s_pad // QUERY_CHUNK
    out = lax.map(attend_chunk, jnp.arange(n_chunks))
    out = out.transpose(1, 0, 3, 2, 4).reshape(B, s_pad, H, Dh)
    return out[:, :S]


def causal_depthwise_conv(x, w, b):
    out = lax.conv_general_dilated(
        x, w[:, None, :], window_strides=(1,), padding=[(CONV_WIDTH - 1, 0)],
        dimension_numbers=('NWC', 'WIO', 'NWC'), feature_group_count=x.shape[-1])
    return out + b


def rg_lru(x, w_r, b_r, w_i, b_i, lam):
    B, S, W = x.shape
    xb = x.reshape(B, S, LRU_BLOCKS, LRU_BLOCK_DIM)
    r = jax.nn.sigmoid((jnp.einsum('bsgi,gij->bsgj', xb, w_r) + b_r).astype(jnp.float32)).reshape(B, S, W)
    i = jax.nn.sigmoid((jnp.einsum('bsgi,gij->bsgj', xb, w_i) + b_i).astype(jnp.float32)).reshape(B, S, W)
    log_a = -LRU_C * r * jax.nn.softplus(-lam.astype(jnp.float32))
    a = jnp.exp(log_a)
    norm = jnp.sqrt(-jnp.expm1(2.0 * log_a))
    u = norm * i * x.astype(jnp.float32)

    def combine(left, right):
        a1, b1 = left
        a2, b2 = right
        return a1 * a2, a2 * b1 + b2

    _, h = lax.associative_scan(combine, (a, u), axis=1)
    return h.astype(x.dtype)


def setup_inputs(seed: int = 0) -> dict:
    key = jax.random.key(seed)
    ks = jax.random.split(key, 20)
    f32 = jnp.float32
    nrm = lambda k, shape, s: jax.random.normal(k, shape, f32) * s
    u = jax.random.uniform(ks[13], (DEPTH, LRU_WIDTH), f32, 0.9, 0.999)
    a0 = u ** (1.0 / LRU_C)
    lru_lambda = jnp.log(a0) - jnp.log1p(-a0)
    return {
        "x": nrm(ks[0], (BATCH, SEQ, D_MODEL), 1.0),
        "c": nrm(ks[1], (BATCH, D_MODEL), 1.0),
        "w_mod": nrm(ks[2], (DEPTH, D_MODEL, 3 * D_MODEL), 0.5 * D_MODEL ** -0.5),
        "b_mod": nrm(ks[3], (DEPTH, 3 * D_MODEL), 0.01),
        "norm_gain": 1.0 + nrm(ks[4], (DEPTH, D_MODEL), 0.02),
        "w_in": nrm(ks[5], (DEPTH, D_MODEL, IN_WIDTH), D_MODEL ** -0.5),
        "conv_w": nrm(ks[6], (DEPTH, CONV_WIDTH, LRU_WIDTH), CONV_WIDTH ** -0.5),
        "conv_b": nrm(ks[7], (DEPTH, LRU_WIDTH), 0.01),
        "w_rgate": nrm(ks[8], (DEPTH, LRU_BLOCKS, LRU_BLOCK_DIM, LRU_BLOCK_DIM), LRU_BLOCK_DIM ** -0.5),
        "b_rgate": nrm(ks[9], (DEPTH, LRU_BLOCKS, LRU_BLOCK_DIM), 0.01),
        "w_igate": nrm(ks[10], (DEPTH, LRU_BLOCKS, LRU_BLOCK_DIM, LRU_BLOCK_DIM), LRU_BLOCK_DIM ** -0.5),
        "b_igate": nrm(ks[11], (DEPTH, LRU_BLOCKS, LRU_BLOCK_DIM), 0.01),
        "lru_lambda": lru_lambda,
        "attn_out_gain": 1.0 + nrm(ks[14], (DEPTH, ATTN_WIDTH), 0.02),
        "lru_out_gain": 1.0 + nrm(ks[15], (DEPTH, LRU_WIDTH), 0.02),
        "w_out": nrm(ks[16], (DEPTH, MIX_WIDTH, D_MODEL), MIX_WIDTH ** -0.5),
        "final_gain": 1.0 + nrm(ks[17], (D_MODEL,), 0.02),
    }


def reference(x, c, w_mod, b_mod, norm_gain, w_in, conv_w, conv_b, w_rgate, b_rgate,
              w_igate, b_igate, lru_lambda, attn_out_gain, lru_out_gain, w_out, final_gain):
    B, S, _ = x.shape
    cos, sin = rope_tables(S)
    c_act = jax.nn.silu(c)
    splits = [ATTN_WIDTH, 2 * ATTN_WIDTH, 3 * ATTN_WIDTH, 4 * ATTN_WIDTH, 4 * ATTN_WIDTH + LRU_WIDTH]
    for l in range(DEPTH):
        mod = c_act @ w_mod[l] + b_mod[l]
        shift, scale, gate = jnp.split(mod, 3, axis=-1)
        h = rmsnorm(x, norm_gain[l]) * (1.0 + scale[:, None, :]) + shift[:, None, :]
        proj = h @ w_in[l]
        q, k, v, z_attn, x_lru, z_lru = jnp.split(proj, splits, axis=-1)

        q = apply_rope(q.reshape(B, S, ATTN_HEADS, HEAD_DIM), cos, sin)
        k = apply_rope(k.reshape(B, S, ATTN_HEADS, HEAD_DIM), cos, sin)
        v = v.reshape(B, S, ATTN_HEADS, HEAD_DIM)
        attn = moba_attention(q, k, v).reshape(B, S, ATTN_WIDTH)
        y_attn = rmsnorm(attn, attn_out_gain[l]) * jax.nn.silu(z_attn)

        xc = causal_depthwise_conv(x_lru, conv_w[l], conv_b[l])
        rec = rg_lru(xc, w_rgate[l], b_rgate[l], w_igate[l], b_igate[l], lru_lambda[l])
        y_lru = rmsnorm(rec, lru_out_gain[l]) * jax.nn.silu(z_lru)

        y = jnp.concatenate([y_attn, y_lru], axis=-1) @ w_out[l]
        x = x + gate[:, None, :] * y
    return rmsnorm(x, final_gain)
```

```cpp
#include <hip/hip_runtime.h>
#include <hip/hip_cooperative_groups.h>
#include <hip/hip_bf16.h>
#include <cstdio>
#include <cstdint>
#include <cmath>
namespace cg = cooperative_groups;
namespace pg8 {
#define PG8_LAS __attribute__((address_space(3)))
typedef unsigned short bf16_t;
typedef short bf16x8 __attribute__((ext_vector_type(8)));
typedef float f32x4 __attribute__((ext_vector_type(4)));
typedef unsigned u32x4 __attribute__((ext_vector_type(4)));
constexpr int BM = 256, BK = 64, HALF = 128, HTB = HALF * BK * 2  , STAGE_BYTES = 8 * HTB, NXCD = 8, WGM = 8;

__host__ __device__ __forceinline__ int lds_byte(int r, int c) { const int st = (r >> 4) * 2 + (c >> 5), rr = r & 15, cc = c & 31, ob = rr * 64 + cc * 2; return st * 1024 + (ob ^ (((ob >> 9) & 1) << 5)); }
__host__ __device__ __forceinline__ void stage_rc(int b, int& R, int& C) { const int st = b / 1024, sb = b % 1024, swz = sb ^ (((sb >> 9) & 1) << 5); R = (st >> 1) * 16 + swz / 64; C = (st & 1) * 32 + (swz % 64) / 2; }
__host__ __device__ __forceinline__ int perm32(int rho) { const int n = rho >> 4, i = rho & 15; return 8 * (i >> 2) + 4 * n + (i & 3); }

struct Unit { int pm, pn; };
struct Gemm { const bf16_t* A; const bf16_t* Bt; int M, N, K; };

struct StaticOrder {
    int nM, nN, nwg, G, c;
    __host__ __device__ void init(int M, int N, int G_, int c_) { nM = M / BM; nN = N / BM; nwg = nM * nN; G = G_; c = c_; }
    __host__ __device__ bool next(int i, Unit& u) const {
        const long L = (long)i * G + c; if (L >= nwg) return false;
        int wgid = (int)L; { const int q = nwg / NXCD, r = nwg % NXCD, xcd = wgid % NXCD, off = wgid / NXCD; wgid = (xcd < r ? xcd * (q + 1) : r * (q + 1) + (xcd - r) * q) + off; }
        const int nig = WGM * nN, gid = wgid / nig, fm = gid * WGM, gsz = (nM - fm) < WGM ? (nM - fm) : WGM;
        u.pm = fm + ((wgid % nig) % gsz); u.pn = (wgid % nig) / gsz; return true;
    }
    __device__ __forceinline__ void a_ready(const Unit&) const {}
    __device__ __forceinline__ void done(const Unit&) const {}
};

__device__ __forceinline__ unsigned cvt_pk_bf16(float lo, float hi) { unsigned r; asm volatile("v_cvt_pk_bf16_f32 %0, %1, %2" : "=v"(r) : "v"(lo), "v"(hi)); return r; }
typedef float f32x2 __attribute__((ext_vector_type(2)));
constexpr float QK_C2 = 0.125f * 1.4426950408889634f;
__device__ __forceinline__ float silu_f(float z) { return z * __builtin_amdgcn_rcpf(1.0f + __builtin_amdgcn_exp2f(-1.4426950408889634f * z)); }
struct EpiIn {
    static constexpr bool PERM = true, AFTER_DRAIN = false, MIDSCALE = false;
    bf16_t* O; size_t sec_stride; const float* ropec; const float* ropes; float* kms; const float* gA; const float* gL;
    __device__ __forceinline__ void mid(f32x4 (&)[2][2][4][2], const Unit&, int, int) const {}
    __device__ __forceinline__ void operator()(const f32x4 (&acc)[2][2][4][2], const Unit& u, int wr, int wc, int fr, int fq) const {
        const int sec = u.pn >> 1, colt = (u.pn & 1) * 256;
        bf16_t* base = O + (size_t)sec * sec_stride;
        const int row0 = u.pm * BM + wr * 64 + fr, col0 = colt + wc * 32 + 8 * fq;
        if (sec <= 1) {
            const float sc = (sec == 0) ? QK_C2 : 1.0f;
            const int dd = 16 * (wc & 1) + 4 * fq;
            f32x4 ks[2][2];
#pragma unroll
            for (int bj = 0; bj < 2; ++bj) { ks[bj][0] = (f32x4){0.f, 0.f, 0.f, 0.f}; ks[bj][1] = (f32x4){0.f, 0.f, 0.f, 0.f}; }
#pragma unroll
            for (int ai = 0; ai < 2; ++ai)
#pragma unroll
                for (int m = 0; m < 4; ++m) {
                    const int row = row0 + ai * HALF + m * 16, pos = row & 2047;
                    const f32x4 cv = *(const f32x4*)(ropec + pos * 32 + dd), sv = *(const f32x4*)(ropes + pos * 32 + dd);
                    bf16_t* rowp = base + (size_t)row * 512 + col0;
#pragma unroll
                    for (int bj = 0; bj < 2; ++bj) {
                        const f32x4 t1 = acc[ai][bj][m][0], t2 = acc[ai][bj][m][1];
                        f32x4 o1 = t1 * cv - t2 * sv, o2 = t2 * cv + t1 * sv;
                        ks[bj][0] += o1; ks[bj][1] += o2;
                        o1 = o1 * sc; o2 = o2 * sc;
                        u32x4 w; w.x = cvt_pk_bf16(o1[0], o1[1]); w.y = cvt_pk_bf16(o1[2], o1[3]); w.z = cvt_pk_bf16(o2[0], o2[1]); w.w = cvt_pk_bf16(o2[2], o2[3]);
                        *(u32x4*)(rowp + bj * HALF) = w;
                    }
                }
            if (sec == 1) {
#pragma unroll
                for (int bj = 0; bj < 2; ++bj)
#pragma unroll
                    for (int n = 0; n < 2; ++n)
#pragma unroll
                        for (int i = 0; i < 4; ++i) {
                            float v = ks[bj][n][i];
                            v += __shfl_xor(v, 1); v += __shfl_xor(v, 2); v += __shfl_xor(v, 4); v += __shfl_xor(v, 8);
                            if (fr == 0) atomicAdd(kms + (size_t)u.pm * 512 + col0 + bj * HALF + 4 * n + i, v);
                        }
            }
        } else if (sec == 2 || sec == 4) {
#pragma unroll
            for (int ai = 0; ai < 2; ++ai)
#pragma unroll
                for (int m = 0; m < 4; ++m) {
                    bf16_t* rowp = base + (size_t)(row0 + ai * HALF + m * 16) * 512 + col0;
#pragma unroll
                    for (int bj = 0; bj < 2; ++bj) {
                        const f32x4 v0 = acc[ai][bj][m][0], v1 = acc[ai][bj][m][1];
                        u32x4 w; w.x = cvt_pk_bf16(v0[0], v0[1]); w.y = cvt_pk_bf16(v0[2], v0[3]); w.z = cvt_pk_bf16(v1[0], v1[1]); w.w = cvt_pk_bf16(v1[2], v1[3]);
                        *(u32x4*)(rowp + bj * HALF) = w;
                    }
                }
        } else {
            const float* gp = (sec == 3) ? gA : gL;
            f32x4 gv[2][2];
#pragma unroll
            for (int bj = 0; bj < 2; ++bj)
#pragma unroll
                for (int n = 0; n < 2; ++n) gv[bj][n] = *(const f32x4*)(gp + col0 + bj * HALF + 4 * n);
#pragma unroll
            for (int ai = 0; ai < 2; ++ai)
#pragma unroll
                for (int m = 0; m < 4; ++m) {
                    bf16_t* rowp = base + (size_t)(row0 + ai * HALF + m * 16) * 512 + col0;
#pragma unroll
                    for (int bj = 0; bj < 2; ++bj) {
                        f32x4 v0 = acc[ai][bj][m][0], v1 = acc[ai][bj][m][1];
#pragma unroll
                        for (int i = 0; i < 4; ++i) { v0[i] = silu_f(v0[i]) * gv[bj][0][i]; v1[i] = silu_f(v1[i]) * gv[bj][1][i]; }
                        u32x4 w; w.x = cvt_pk_bf16(v0[0], v0[1]); w.y = cvt_pk_bf16(v0[2], v0[3]); w.z = cvt_pk_bf16(v1[0], v1[1]); w.w = cvt_pk_bf16(v1[2], v1[3]);
                        *(u32x4*)(rowp + bj * HALF) = w;
                    }
                }
        }
    }
};
struct EpiOut {
    static constexpr bool PERM = false, AFTER_DRAIN = false, MIDSCALE = true;
    const float* x; float* out; const float* gate; const float* ssA; const float* ssL; float* ssx;
    __device__ __forceinline__ void scales(int row, float& ra, float& rl) const {
        const f32x4* pa = (const f32x4*)(ssA + (size_t)row * 8); const f32x4* pl = (const f32x4*)(ssL + (size_t)row * 8);
        const f32x4 a0 = pa[0], a1 = pa[1], l0 = pl[0], l1 = pl[1];
        const float sa = ((a0[0] + a0[1]) + (a0[2] + a0[3])) + ((a1[0] + a1[1]) + (a1[2] + a1[3]));
        const float sl = ((l0[0] + l0[1]) + (l0[2] + l0[3])) + ((l1[0] + l1[1]) + (l1[2] + l1[3]));
        ra = 1.0f / sqrtf(sa * (1.0f / 512.0f) + 1e-6f); rl = 1.0f / sqrtf(sl * (1.0f / 512.0f) + 1e-6f);
    }
    __device__ __forceinline__ void mid(f32x4 (&acc)[2][2][4][2], const Unit& u, int wr, int fr) const {
        asm volatile("" : "+v"(fr));
#pragma unroll
        for (int ai = 0; ai < 2; ++ai)
#pragma unroll
            for (int m = 0; m < 4; ++m) {
                float ra, rl; scales(u.pm * BM + ai * HALF + wr * 64 + m * 16 + fr, ra, rl);
                const float f = ra / rl;
#pragma unroll
                for (int bj = 0; bj < 2; ++bj)
#pragma unroll
                    for (int n = 0; n < 2; ++n) acc[ai][bj][m][n] = acc[ai][bj][m][n] * f;
                asm volatile("" ::: "memory");
            }
    }
    __device__ __forceinline__ void operator()(const f32x4 (&acc)[2][2][4][2], const Unit& u, int wr, int wc, int fr, int fq) const {
        asm volatile("" : "+v"(fr), "+v"(fq));
        const int col0 = u.pn * BM + wc * 32 + 4 * fq;
        const float* gp = gate + (size_t)(u.pm >> 3) * 3072 + col0;
        f32x4 gv[2][2];
#pragma unroll
        for (int bj = 0; bj < 2; ++bj)
#pragma unroll
            for (int n = 0; n < 2; ++n) gv[bj][n] = *(const f32x4*)(gp + bj * HALF + n * 16);
#pragma unroll
        for (int ai = 0; ai < 2; ++ai)
#pragma unroll
            for (int m = 0; m < 4; ++m) {
                const int row = u.pm * BM + ai * HALF + wr * 64 + m * 16 + fr;
                float ra, rl; scales(row, ra, rl);
                const size_t off = (size_t)row * 1024 + col0; float ss = 0.f;
#pragma unroll
                for (int bj = 0; bj < 2; ++bj)
#pragma unroll
                    for (int n = 0; n < 2; ++n) {
                        const f32x4 xv = *(const f32x4*)(x + off + bj * HALF + n * 16);
                        const f32x4 o = xv + gv[bj][n] * (acc[ai][bj][m][n] * rl);
                        ss += (o[0] * o[0] + o[1] * o[1]) + (o[2] * o[2] + o[3] * o[3]);
                        *(f32x4*)(out + off + bj * HALF + n * 16) = o;
                    }
                ss += __shfl_xor(ss, 16); ss += __shfl_xor(ss, 32);
                if (fq == 0) ssx[(size_t)row * 16 + u.pn * 4 + wc] = ss;
                asm volatile("" ::: "memory");
            }
    }
};

template <class Epi, class Sched, bool ALIGN_EPI = false, bool SP2 = false>
__device__ __forceinline__ void gemm_phase(PG8_LAS unsigned char* lds, const Gemm g, const Sched& S, const Epi& E) {
    int tid_l = threadIdx.x; asm volatile("" : "+v"(tid_l));
    const int tid = tid_l, wid = __builtin_amdgcn_readfirstlane(tid >> 6), lane = tid & 63, wr = wid >> 2, wc = wid & 3, fr = lane & 15, fq = lane >> 4;
    const int K = g.K, nt = K / BK;
    unsigned voffA[2], voffB[2];
#pragma unroll
    for (int i = 0; i < 2; ++i) { int R, C; stage_rc(tid * 16 + i * 8192, R, C); const int Rb = Epi::PERM ? ((R & ~31) + perm32(R & 31)) : R;
        voffA[i] = (unsigned)(R * K + C) * 2u; voffB[i] = (unsigned)(Rb * K + C) * 2u; }
    const size_t kstep = (size_t)(BK * 2);
    const size_t hstep = (size_t)HALF * K * 2;
    const size_t tstep = 2 * hstep;
    const unsigned ldsw = (unsigned)wid * 1024u;
    const int aoff = lds_byte(wr * 64 + fr, fq * 8), boff = lds_byte(wc * 32 + fr, fq * 8);
#define PG8_SA(b, h) (((b) * 2 + (h)) * HTB)
#define PG8_SB(b, h) ((4 + (b) * 2 + (h)) * HTB)
#define PG8_STAGE(bufoff, gbase, voff) do { _Pragma("unroll") for (int _i = 0; _i < 2; ++_i) \
        __builtin_amdgcn_global_load_lds((const unsigned*)((const char*)(gbase) + (voff)[_i]), (PG8_LAS unsigned*)(lds + (bufoff) + ldsw + _i * 8192), 16, 0, 0); } while (0)
#define PG8_LDA(dst, b, h) do { _Pragma("unroll") for (int m = 0; m < 4; ++m) _Pragma("unroll") for (int k = 0; k < 2; ++k) dst[m][k] = *(const PG8_LAS bf16x8*)(lds + PG8_SA(b, h) + aoff + m * 2048 + k * 1024); } while (0)
#define PG8_LDB(dst, b, h) do { _Pragma("unroll") for (int n = 0; n < 2; ++n) _Pragma("unroll") for (int k = 0; k < 2; ++k) dst[n][k] = *(const PG8_LAS bf16x8*)(lds + PG8_SB(b, h) + boff + n * 2048 + k * 1024); } while (0)
#define PG8_MMA(ai, bj, At, Bt) do { __builtin_amdgcn_s_setprio(1); _Pragma("unroll") for (int m = 0; m < 4; ++m) _Pragma("unroll") for (int n = 0; n < 2; ++n) _Pragma("unroll") for (int k = 0; k < 2; ++k) \
        acc[ai][bj][m][n] = __builtin_amdgcn_mfma_f32_16x16x32_bf16(Bt[n][k], At[m][k], acc[ai][bj][m][n], 0, 0, 0); __builtin_amdgcn_s_setprio(0); } while (0)
#define PG8_WAIT_V(n) asm volatile("s_waitcnt vmcnt(" #n ")" ::: "memory")
#define PG8_WAIT_L(n) asm volatile("s_waitcnt lgkmcnt(" #n ")" ::: "memory")
#define PG8_BAR __builtin_amdgcn_s_barrier()
#define PG8_SCHED __builtin_amdgcn_sched_barrier(0)
    Unit cur, nxt; int ui = 0;
    if (!S.next(0, cur)) return;
    f32x4 acc[2][2][4][2];
#pragma unroll
    for (int a = 0; a < 2; ++a)
#pragma unroll
        for (int b = 0; b < 2; ++b)
#pragma unroll
            for (int m = 0; m < 4; ++m)
#pragma unroll
                for (int n = 0; n < 2; ++n) acc[a][b][m][n] = (f32x4){0.f, 0.f, 0.f, 0.f};
    bf16x8 At[4][2], B0[2][2], B1[2][2];
    const char* cA = (const char*)g.A + (size_t)cur.pm * tstep; const char* cB = (const char*)g.Bt + (size_t)cur.pn * tstep;
    S.a_ready(cur);
    if constexpr (SP2) {
        PG8_STAGE(PG8_SB(0, 0), cB, voffB); PG8_STAGE(PG8_SB(0, 1), cB + hstep, voffB); PG8_STAGE(PG8_SA(0, 0), cA, voffA); PG8_STAGE(PG8_SA(0, 1), cA + hstep, voffA);
        if (wr == 1) PG8_BAR;
        PG8_WAIT_V(2); PG8_BAR;
        PG8_STAGE(PG8_SB(1, 0), cB + kstep, voffB); PG8_STAGE(PG8_SA(1, 0), cA + kstep, voffA); PG8_STAGE(PG8_SB(1, 1), cB + hstep + kstep, voffB);
        PG8_WAIT_V(6); PG8_BAR;
    } else {
        PG8_STAGE(PG8_SB(0, 0), cB, voffB); PG8_STAGE(PG8_SA(0, 0), cA, voffA); PG8_STAGE(PG8_SB(0, 1), cB + hstep, voffB); PG8_STAGE(PG8_SA(0, 1), cA + hstep, voffA);
        if (wr == 1) PG8_BAR;
        PG8_WAIT_V(4); PG8_BAR;
        PG8_STAGE(PG8_SB(1, 0), cB + kstep, voffB); PG8_STAGE(PG8_SA(1, 0), cA + kstep, voffA); PG8_STAGE(PG8_SB(1, 1), cB + hstep + kstep, voffB);
        PG8_WAIT_V(6); PG8_BAR;
    }
    for (;;) {
        const bool has_next = S.next(ui + 1, nxt);
        const char* nA = has_next ? (const char*)g.A + (size_t)nxt.pm * tstep : cA; const char* nB = has_next ? (const char*)g.Bt + (size_t)nxt.pn * tstep : cB;
        for (int t = 0; t < nt; t += 2) {
            if constexpr (Epi::MIDSCALE) { if (t == nt / 2) E.mid(acc, cur, wr, fr); }
            const bool last = (t == nt - 2);
            const char* a1 = cA + (size_t)(t + 1) * kstep;
            const char* a2 = last ? nA : cA + (size_t)(t + 2) * kstep; const char* b2 = last ? nB : cB + (size_t)(t + 2) * kstep;
            const char* a3 = a2 + kstep; const char* b3 = b2 + kstep;
            if (last && has_next) S.a_ready(nxt);
            if constexpr (SP2) {
            PG8_LDB(B0, 0, 0); PG8_LDB(B1, 0, 1); PG8_SCHED; PG8_LDA(At, 0, 0); PG8_STAGE(PG8_SA(1, 1), a1 + hstep, voffA);
            PG8_WAIT_V(8); PG8_WAIT_L(0); PG8_BAR; PG8_MMA(0, 0, At, B0); PG8_MMA(0, 1, At, B1); PG8_BAR; PG8_SCHED;
            PG8_LDA(At, 0, 1); PG8_STAGE(PG8_SB(0, 0), b2, voffB); PG8_STAGE(PG8_SB(0, 1), b2 + hstep, voffB); PG8_STAGE(PG8_SA(0, 0), a2, voffA);
            PG8_WAIT_V(8); PG8_WAIT_L(0); PG8_BAR; PG8_MMA(1, 0, At, B0); PG8_MMA(1, 1, At, B1); PG8_BAR; PG8_SCHED;
            PG8_LDB(B0, 1, 0); PG8_LDB(B1, 1, 1); PG8_SCHED; PG8_LDA(At, 1, 0); PG8_STAGE(PG8_SA(0, 1), a2 + hstep, voffA);
            PG8_WAIT_V(8); PG8_WAIT_L(0); PG8_BAR; PG8_MMA(0, 0, At, B0); PG8_MMA(0, 1, At, B1); PG8_BAR; PG8_SCHED;
            PG8_LDA(At, 1, 1); PG8_STAGE(PG8_SB(1, 0), b3, voffB); PG8_STAGE(PG8_SB(1, 1), b3 + hstep, voffB); PG8_STAGE(PG8_SA(1, 0), a3, voffA);
            PG8_WAIT_V(8); PG8_WAIT_L(0); PG8_BAR; PG8_MMA(1, 0, At, B0); PG8_MMA(1, 1, At, B1); PG8_BAR; PG8_SCHED;
            } else {
            PG8_LDB(B0, 0, 0); PG8_SCHED; PG8_LDA(At, 0, 0); PG8_STAGE(PG8_SA(1, 1), a1 + hstep, voffA);
            PG8_WAIT_L(8); PG8_BAR; PG8_WAIT_L(0); PG8_MMA(0, 0, At, B0); PG8_BAR; PG8_SCHED;
            PG8_LDB(B1, 0, 1); PG8_STAGE(PG8_SB(0, 0), b2, voffB);
            PG8_BAR; PG8_WAIT_L(0); PG8_MMA(0, 1, At, B1); PG8_BAR;
            PG8_LDA(At, 0, 1); PG8_STAGE(PG8_SA(0, 0), a2, voffA);
            PG8_BAR; PG8_WAIT_L(0); PG8_MMA(1, 0, At, B0); PG8_BAR; PG8_SCHED;
            PG8_STAGE(PG8_SB(0, 1), b2 + hstep, voffB);
            PG8_WAIT_V(6); PG8_BAR; PG8_MMA(1, 1, At, B1); PG8_BAR;
            PG8_LDB(B0, 1, 0); PG8_SCHED; PG8_LDA(At, 1, 0); PG8_STAGE(PG8_SA(0, 1), a2 + hstep, voffA);
            PG8_WAIT_L(8); PG8_BAR; PG8_WAIT_L(0); PG8_MMA(0, 0, At, B0); PG8_BAR; PG8_SCHED;
            PG8_LDB(B1, 1, 1); PG8_STAGE(PG8_SB(1, 0), b3, voffB);
            PG8_BAR; PG8_WAIT_L(0); PG8_MMA(0, 1, At, B1); PG8_BAR;
            PG8_LDA(At, 1, 1); PG8_STAGE(PG8_SA(1, 0), a3, voffA);
            PG8_BAR; PG8_WAIT_L(0); PG8_MMA(1, 0, At, B0); PG8_BAR; PG8_SCHED;
            PG8_STAGE(PG8_SB(1, 1), b3 + hstep, voffB);
            PG8_WAIT_V(6); PG8_BAR; PG8_MMA(1, 1, At, B1); PG8_BAR;
            }
        }
        if constexpr (ALIGN_EPI) { if (wr == 0) PG8_BAR; }
        if constexpr (!Epi::AFTER_DRAIN) { E(acc, cur, wr, wc, fr, fq); S.done(cur); }
        if (!has_next) break;
#pragma unroll
        for (int a = 0; a < 2; ++a)
#pragma unroll
            for (int b = 0; b < 2; ++b)
#pragma unroll
                for (int m = 0; m < 4; ++m)
#pragma unroll
                    for (int n = 0; n < 2; ++n) acc[a][b][m][n] = (f32x4){0.f, 0.f, 0.f, 0.f};
        cur = nxt; cA = nA; cB = nB; ++ui;
        if constexpr (ALIGN_EPI) { if (wr == 1) PG8_BAR; }
    }
    PG8_WAIT_V(0);
    if constexpr (!ALIGN_EPI) { if (wr == 0) PG8_BAR; }
    PG8_BAR;
    if constexpr (Epi::AFTER_DRAIN) { E.fused(acc, cur, wr, wc, fr, fq, lds, wid, lane); S.done(cur); }
#undef PG8_SA
#undef PG8_SB
#undef PG8_STAGE
#undef PG8_LDA
#undef PG8_LDB
#undef PG8_MMA
#undef PG8_WAIT_V
#undef PG8_WAIT_L
#undef PG8_BAR
#undef PG8_SCHED
}
}
#define PG8_SP2 true
#define PG8_ALIGN true
namespace attn_body {
using bf16=__hip_bfloat16;
using bf16x8=__attribute__((ext_vector_type(8)))short;
using s16x4=__attribute__((ext_vector_type(4)))short;
using f32x16=__attribute__((ext_vector_type(16)))float;
using u32x4=__attribute__((ext_vector_type(4)))unsigned;
using f32x4v=__attribute__((ext_vector_type(4)))float;
constexpr int BATCH=32,NHEAD=8,SEQ=2048,D=64,DM=NHEAD*D;
constexpr int NW=8,QBLK=32,QB=QBLK*NW,KVBLK=64,NQB=SEQ/QB;
constexpr int ATTN_PITCH=DM, ATTN_UNIT_ROWS=QB;
__device__ __forceinline__ int crow(int r,int hi){return (r&3)+8*(r>>2)+4*hi;}
#define SBAR() __builtin_amdgcn_sched_barrier(0)
__device__ __forceinline__ void cmask(f32x16&p0,f32x16&p1,int jb,int qrel,int hi){
  const float NEG=-INFINITY; int kb=64*jb+4*hi;
  #pragma unroll
  for(int r=0;r<16;++r){int kv=kb+(r&3)+8*(r>>2); if(kv>qrel)p0[r]=NEG; if(kv+32>qrel)p1[r]=NEG;}
}

constexpr int NSLOT=3, SLOTB=8192;
constexpr int LDS_K=0, LDS_V=NSLOT*SLOTB, LDS_WS=2*NSLOT*SLOTB, LDS_OST=LDS_WS+NW*64*4, LDS_BYTES=LDS_OST+NW*4096;
constexpr float C2=0.125f*1.4426950408889634f;
__device__ __forceinline__ void glds16(const void*gsrc,unsigned lds_dst){unsigned keep;
  asm volatile("s_mov_b32 %0, m0\n\ts_mov_b32 m0, %2\n\ts_nop 0\n\tglobal_load_lds_dwordx4 %1, off\n\ts_mov_b32 m0, %0":"=&s"(keep):"v"(gsrc),"s"(lds_dst):"memory");}
__device__ __forceinline__ float max3f(float a,float b,float c){float r;asm("v_max3_f32 %0, %1, %2, %3":"=v"(r):"v"(a),"v"(b),"v"(c));return r;}
__device__ __forceinline__ float max2f(float a,float b){float r;asm("v_max_f32_e32 %0, %1, %2":"=v"(r):"v"(a),"v"(b));return r;}
__device__ __forceinline__ float fadd_s(float a,float b){float r;asm("v_add_f32_e32 %0, %1, %2":"=v"(r):"v"(a),"v"(b));return r;}
__device__ __forceinline__ float fsub_s(float a,float b){float r;asm("v_sub_f32_e32 %0, %1, %2":"=v"(r):"v"(a),"v"(b));return r;}
typedef float f32x2_t __attribute__((ext_vector_type(2))); typedef __bf16 bf16x2_t __attribute__((ext_vector_type(2)));
__device__ __forceinline__ unsigned cvtpk_s(float lo,float hi){f32x2_t v={lo,hi};bf16x2_t b=__builtin_convertvector(v,bf16x2_t);return __builtin_bit_cast(unsigned,b);}
#define WAIT_BAR(N) asm volatile("s_waitcnt vmcnt(" #N ") lgkmcnt(0)\n\ts_barrier":::"memory")

__device__ __forceinline__ void qkt(f32x16&p0,f32x16&p1,const char*Kslot,const bf16x8*qr,const f32x16&negm,int r32,int hi){
  const char*kb=Kslot+hi*1024+r32*16;
  #pragma unroll
  for(int d0=0;d0<4;++d0){
    const bf16x8 b0=*reinterpret_cast<const bf16x8*>(kb+d0*2048);
    const bf16x8 b1=*reinterpret_cast<const bf16x8*>(kb+d0*2048+512);
    if(d0==0){p0=__builtin_amdgcn_mfma_f32_32x32x16_bf16(b0,qr[0],negm,0,0,0);p1=__builtin_amdgcn_mfma_f32_32x32x16_bf16(b1,qr[0],negm,0,0,0);}
    else{p0=__builtin_amdgcn_mfma_f32_32x32x16_bf16(b0,qr[d0],p0,0,0,0);p1=__builtin_amdgcn_mfma_f32_32x32x16_bf16(b1,qr[d0],p1,0,0,0);}}
}
typedef __attribute__((address_space(3))) const char* lds_cptr;
typedef short v4i16_t __attribute__((ext_vector_type(4)));
__device__ __forceinline__ void kload8(bf16x8*kf,lds_cptr kp){
  kf[0]=*(const __attribute__((address_space(3))) bf16x8*)(kp);      kf[1]=*(const __attribute__((address_space(3))) bf16x8*)(kp+512);
  kf[2]=*(const __attribute__((address_space(3))) bf16x8*)(kp+2048); kf[3]=*(const __attribute__((address_space(3))) bf16x8*)(kp+2560);
  kf[4]=*(const __attribute__((address_space(3))) bf16x8*)(kp+4096); kf[5]=*(const __attribute__((address_space(3))) bf16x8*)(kp+4608);
  kf[6]=*(const __attribute__((address_space(3))) bf16x8*)(kp+6144); kf[7]=*(const __attribute__((address_space(3))) bf16x8*)(kp+6656);
}
__device__ __forceinline__ void kload2(bf16x8*kf,lds_cptr kp,int j){ kf[2*j]=*(const __attribute__((address_space(3))) bf16x8*)(kp+j*2048); kf[2*j+1]=*(const __attribute__((address_space(3))) bf16x8*)(kp+j*2048+512); }
__device__ __forceinline__ s16x4 vtr(lds_cptr p){ return __builtin_bit_cast(s16x4,__builtin_amdgcn_ds_read_tr16_b64_v4i16((__attribute__((address_space(3))) v4i16_t*)p)); }
__device__ __forceinline__ float rowmax(const f32x16&p0,const f32x16&p1){
  float a=max3f(p0[0],p0[1],p1[0]),b=max3f(p0[2],p0[3],p1[1]);a=max3f(a,p1[2],p1[3]);
  #pragma unroll
  for(int r=4;r<16;r+=4){a=max3f(a,p0[r],p0[r+1]);b=max3f(b,p0[r+2],p0[r+3]);a=max3f(a,p1[r],p1[r+1]);b=max3f(b,p1[r+2],p1[r+3]);}
  const float m=max2f(a,b);
  auto rr=__builtin_amdgcn_permlane32_swap(__float_as_uint(m),__float_as_uint(m),false,false);
  return max2f(__uint_as_float(rr[0]),__uint_as_float(rr[1]));
}
__device__ __forceinline__ void pv(f32x16*o,int vb,bf16x8 pa0,bf16x8 pa1,bf16x8 pa2,bf16x8 pa3){
  #pragma unroll
  for(int d0=0;d0<2;++d0){s16x4 lo[4],hi[4];
    #pragma unroll
    for(int ks=0;ks<4;++ks){
      asm volatile("ds_read_b64_tr_b16 %0,%1 offset:%c2":"=&v"(lo[ks]):"v"(vb),"i"(d0*4096+ks*1024):"memory");
      asm volatile("ds_read_b64_tr_b16 %0,%1 offset:%c2":"=&v"(hi[ks]):"v"(vb),"i"(d0*4096+ks*1024+512):"memory");}
    asm volatile("s_waitcnt lgkmcnt(0)":::"memory");SBAR();
    #define PK(k) (bf16x8){lo[k][0],lo[k][1],lo[k][2],lo[k][3],hi[k][0],hi[k][1],hi[k][2],hi[k][3]}
    o[d0]=__builtin_amdgcn_mfma_f32_32x32x16_bf16(pa0,PK(0),o[d0],0,0,0);
    o[d0]=__builtin_amdgcn_mfma_f32_32x32x16_bf16(pa1,PK(1),o[d0],0,0,0);
    o[d0]=__builtin_amdgcn_mfma_f32_32x32x16_bf16(pa2,PK(2),o[d0],0,0,0);
    o[d0]=__builtin_amdgcn_mfma_f32_32x32x16_bf16(pa3,PK(3),o[d0],0,0,0);
    #undef PK
  }
}

#ifndef ATTN_STORE16
#define ATTN_STORE16(p,v) (*(u32x4*)(p)=(v))
#endif
__device__ __forceinline__ float bf2f(short v){return __uint_as_float(((unsigned)(unsigned short)v)<<16);}
template<int THRL> __device__ __forceinline__ void attn_unit(int b,int h,int qb,const bf16*Q,const bf16*__restrict__ K,const bf16*__restrict__ V,const bf16*__restrict__ G,bf16*Y,float*ssA,const float*__restrict__ kms,char*shm){
  int tid_l=threadIdx.x; asm volatile("":"+v"(tid_l));
  const int tid=tid_l,lane=tid&63,r32=lane&31,hi=lane>>5; const int wid=__builtin_amdgcn_readfirstlane(tid>>6);
  const long rowbase=(long)b*SEQ; const int q0=qb*QB;
  const bf16*Qw=Q+(rowbase+q0+wid*QBLK)*DM+h*D;
  const bf16*Kh=K+rowbase*DM+h*D,*Vh=V+rowbase*DM+h*D;
  const unsigned lds0=(unsigned)(uintptr_t)shm;
  float*wsf=(float*)(shm+LDS_WS)+wid*64;
  const bf16*ksrc=Kh+(long)lane*DM+wid*8;
  const bf16*vsrc=Vh+(long)(16*(wid&3)+(lane>>2))*DM+(wid>>2)*32+(lane&3)*8;
  const unsigned kdst=lds0+LDS_K+wid*1024, vdst=lds0+LDS_V+wid*1024;
  #define PHYS(t) (((t)<4)?(4*qb+(t)):((t)-4))
  #define DMA_K(t,slot) glds16(ksrc+(long)PHYS(t)*KVBLK*DM,(unsigned)__builtin_amdgcn_readfirstlane(kdst+(slot)))
  #define DMA_V(t,slot) glds16(vsrc+(long)PHYS(t)*KVBLK*DM,(unsigned)__builtin_amdgcn_readfirstlane(vdst+(slot)))
  const int vb0=(int)(lds0+LDS_V)+((lane>>4)&1)*32+(lane&3)*8+(4*hi+((lane&15)>>2))*64;
  const char*Kbase=shm+LDS_K; bf16x8 kf[8];
  const lds_cptr shm3=(lds_cptr)shm; const lds_cptr kp0=shm3+LDS_K+hi*1024+r32*16; const lds_cptr vp0=shm3+LDS_V+((lane>>4)&1)*32+(lane&3)*8+(4*hi+((lane&15)>>2))*64;
  const int NT=(q0+QB)/KVBLK;
  DMA_K(0,0);DMA_V(0,0);DMA_K(1,SLOTB);
  bf16x8 qr[4];
  #pragma unroll
  for(int d0=0;d0<4;++d0)qr[d0]=*reinterpret_cast<const bf16x8*>(&Qw[(long)r32*DM+d0*16+hi*8]);
  float mhat=0.f,l_reg=0.f;f32x16 o[2];o[0]=f32x16{};o[1]=f32x16{};f32x16 negm; { float z0_; asm volatile("v_mov_b32 %0, 0":"=v"(z0_)); _Pragma("unroll") for(int r=0;r<16;++r)negm[r]=z0_; } asm volatile("":"+v"(negm));
  const int qrel=wid*QBLK+r32;
  #define CMASK(P0,P1,t) do{ if((t)<4)cmask(P0,P1,(t),qrel,hi);}while(0)
  bool resc=false;
  #define START(P0,P1) do{ const float rm=rowmax(P0,P1); resc=false; \
    { const float dl=rm; mhat=fadd_s(mhat,dl); \
      _Pragma("unroll") for(int r=0;r<16;++r){P0[r]=fsub_s(P0[r],dl);P1[r]=fsub_s(P1[r],dl);} \
      _Pragma("unroll") for(int r=0;r<16;++r)negm[r]=-mhat; asm volatile("":"+v"(negm)); } \
    _Pragma("unroll") for(int r=0;r<16;++r)P0[r]=__builtin_amdgcn_exp2f(P0[r]); }while(0)
  #define RESC() do{ if(resc){ asm volatile("s_waitcnt lgkmcnt(0)":::"memory"); \
      _Pragma("unroll") for(int d_=0;d_<2;++d_) _Pragma("unroll") for(int r=0;r<16;++r)o[d_][r]*=wsf[crow(r,hi)]; } }while(0)
  f32x16 pA0,pA1,pB0,pB1;
  int sl_prev=0,sl_cur=0,sl_next=SLOTB;
  #define ROT() do{sl_prev=sl_cur;sl_cur=sl_next;sl_next=(sl_next==(NSLOT-1)*SLOTB)?0:sl_next+SLOTB;}while(0)
  DMA_K(2,2*SLOTB);
  unsigned selbits=0u;
  { float gsc[7]; int hi_s=hi; asm volatile("":"+v"(hi_s));
    #pragma unroll
    for(int n=0;n<7;++n){ float sg=-INFINITY;
      if(n<qb){ const float*kp=kms+((size_t)(b*8+n)*512+h*64+hi_s*8); sg=0.f;
        #pragma unroll
        for(int d0=0;d0<4;++d0){ const f32x4v k0=*(const f32x4v*)(kp+16*d0), k1=*(const f32x4v*)(kp+16*d0+4);
          sg+=bf2f(qr[d0][0])*k0[0]+bf2f(qr[d0][1])*k0[1]+bf2f(qr[d0][2])*k0[2]+bf2f(qr[d0][3])*k0[3]+bf2f(qr[d0][4])*k1[0]+bf2f(qr[d0][5])*k1[1]+bf2f(qr[d0][6])*k1[2]+bf2f(qr[d0][7])*k1[3]; }
        sg+=__shfl_xor(sg,32); }
      gsc[n]=sg; }
    #pragma unroll
    for(int n=0;n<7;++n){ int rank=0;
      #pragma unroll
      for(int m2=0;m2<7;++m2){ if(m2!=n) rank+=((gsc[m2]>gsc[n])||(gsc[m2]==gsc[n]&&m2<n))?1:0; }
      if(n<qb&&rank<3) selbits|=(1u<<n); } }
  WAIT_BAR(3);
  qkt(pA0,pA1,Kbase,qr,negm,r32,hi);asm volatile("s_nop 15\n\ts_nop 7":"+v"(pA0),"+v"(pA1));CMASK(pA0,pA1,0);
  START(pA0,pA1);
  _Pragma("unroll") for(int r=0;r<16;++r)pA1[r]=__builtin_amdgcn_exp2f(pA1[r]);
  WAIT_BAR(0);
  DMA_K(3,0);DMA_V(1,SLOTB);
  ROT();
  kload8(kf,kp0+sl_cur);
  WAIT_BAR(2);
  s16x4 vlo[8],vhi[8]; u32x4 pw0,pw1,pw2,pw3;
  #define PKW(P,B) cvtpk_s(P[B],P[B+1])
  #define PAF(k) __builtin_bit_cast(bf16x8,pw##k)
  #define VFR(i) (bf16x8){vlo[i][0],vlo[i][1],vlo[i][2],vlo[i][3],vhi[i][0],vhi[i][1],vhi[i][2],vhi[i][3]}
  #define PIN(x) asm volatile("":"+v"(x))
  #define MX3(a,b,c) __builtin_fmaxf(__builtin_fmaxf((a),(b)),(c))
  #define GAPA(MF,A0,A1,A2,A3,W0,W1,PW) do{ MF; sacc+=A0; sacc+=A1; sacc+=A2; sacc+=A3; PIN(sacc); W0; W1; PIN(PW); SBAR(); }while(0)
  #define EX(v) __builtin_amdgcn_exp2f(v)
  #define GAPB(MF,X,B) do{ MF; X[B]=EX(X[B]); X[B+1]=EX(X[B+1]); X[B+2]=EX(X[B+2]); X[B+3]=EX(X[B+3]); PIN(X); SBAR(); }while(0)
  #define VRD(i) do{ vlo[i]=vtr(vp_+(((i)>>2)*4096+((i)&3)*1024)); vhi[i]=vtr(vp_+(((i)>>2)*4096+((i)&3)*1024+512)); }while(0)
  #define KRD(G,j) do{ if(G){ kload2(kf,kp0+sl_next,j); SBAR(); } }while(0)
  #define STEP(C0,C1,P0,P1,t,GK,GV,GL) do{ SBAR(); \
    const lds_cptr vp_=vp0+sl_prev; \
    VRD(0); SBAR(); float sacc=(P0[0]+P0[1]); \
    GAPA(C0=__builtin_amdgcn_mfma_f32_32x32x16_bf16(kf[0],qr[0],negm,0,0,0), P0[2],P0[3],P0[4],P0[5],     pw0[0]=PKW(P0,0), pw0[1]=PKW(P0,2), pw0); \
    VRD(4); SBAR(); GAPA(C1=__builtin_amdgcn_mfma_f32_32x32x16_bf16(kf[1],qr[0],negm,0,0,0), P0[6],P0[7],P0[8],P0[9],     pw0[2]=PKW(P0,4), pw0[3]=PKW(P0,6), pw0); \
    VRD(1); SBAR(); GAPA(C0=__builtin_amdgcn_mfma_f32_32x32x16_bf16(kf[2],qr[1],C0,0,0,0),   P0[10],P0[11],P0[12],P0[13], pw1[0]=PKW(P0,8), pw1[1]=PKW(P0,10), pw1); \
    VRD(5); SBAR(); GAPA(C1=__builtin_amdgcn_mfma_f32_32x32x16_bf16(kf[3],qr[1],C1,0,0,0),   P0[14],P0[15],P1[0],P1[1],   pw1[2]=PKW(P0,12),pw1[3]=PKW(P0,14), pw1); \
    VRD(2); SBAR(); GAPA(C0=__builtin_amdgcn_mfma_f32_32x32x16_bf16(kf[4],qr[2],C0,0,0,0),   P1[2],P1[3],P1[4],P1[5],     pw2[0]=PKW(P1,0), pw2[1]=PKW(P1,2), pw2); \
    VRD(6); SBAR(); GAPA(C1=__builtin_amdgcn_mfma_f32_32x32x16_bf16(kf[5],qr[2],C1,0,0,0),   P1[6],P1[7],P1[8],P1[9],     pw2[2]=PKW(P1,4), pw2[3]=PKW(P1,6), pw2); \
    VRD(3); SBAR(); GAPA(C0=__builtin_amdgcn_mfma_f32_32x32x16_bf16(kf[6],qr[3],C0,0,0,0),   P1[10],P1[11],P1[12],P1[13], pw3[0]=PKW(P1,8), pw3[1]=PKW(P1,10), pw3); \
    VRD(7); SBAR(); GAPA(C1=__builtin_amdgcn_mfma_f32_32x32x16_bf16(kf[7],qr[3],C1,0,0,0),   P1[14],P1[15],0.f,0.f,       pw3[2]=PKW(P1,12),pw3[3]=PKW(P1,14), pw3); \
    l_reg+=sacc; \
    if(GK){DMA_K((t)+3,sl_cur);} if(GV){DMA_V((t)+1,sl_next);} \
    CMASK(C0,C1,t); \
    if((t)>=4){ const bool off_=(((selbits>>((((t)-4)>>2)&7))&1u)==0u); _Pragma("unroll") for(int r=0;r<16;++r){C0[r]=off_?-INFINITY:C0[r];C1[r]=off_?-INFINITY:C1[r];} } \
    { float a=MX3(C0[0],C0[1],C1[0]),b=MX3(C0[2],C0[3],C1[1]); a=MX3(a,C1[2],C1[3]); \
      _Pragma("unroll") for(int r=4;r<16;r+=4){a=MX3(a,C0[r],C0[r+1]);b=MX3(b,C0[r+2],C0[r+3]);a=MX3(a,C1[r],C1[r+1]);b=MX3(b,C1[r+2],C1[r+3]);} \
      float rm=__builtin_fmaxf(a,b); { auto rr=__builtin_amdgcn_permlane32_swap(__float_as_uint(rm),__float_as_uint(rm),false,false); rm=__builtin_fmaxf(__uint_as_float(rr[0]),__uint_as_float(rr[1])); } \
      resc=false; \
      if(__builtin_expect(__any(rm>(float)THRL),0)){ const float dl=__builtin_fmaxf(rm,0.f); mhat+=dl; \
        _Pragma("unroll") for(int r=0;r<16;++r){C0[r]-=dl;C1[r]-=dl;} \
        _Pragma("unroll") for(int r=0;r<16;++r)negm[r]=-mhat; asm volatile("":"+v"(negm)); \
        const float f=__builtin_amdgcn_exp2f(-dl); l_reg*=f; if(hi==0)wsf[r32]=f; resc=true; } } \
    SBAR(); \
    GAPB(o[0]=__builtin_amdgcn_mfma_f32_32x32x16_bf16(PAF(0),VFR(0),o[0],0,0,0), C0,0); \
    GAPB(o[1]=__builtin_amdgcn_mfma_f32_32x32x16_bf16(PAF(0),VFR(4),o[1],0,0,0), C0,4); \
    KRD(GL,0); GAPB(o[0]=__builtin_amdgcn_mfma_f32_32x32x16_bf16(PAF(1),VFR(1),o[0],0,0,0), C0,8); \
    KRD(GL,1); GAPB(o[1]=__builtin_amdgcn_mfma_f32_32x32x16_bf16(PAF(1),VFR(5),o[1],0,0,0), C0,12); \
    KRD(GL,2); GAPB(o[0]=__builtin_amdgcn_mfma_f32_32x32x16_bf16(PAF(2),VFR(2),o[0],0,0,0), C1,0); \
    KRD(GL,3); GAPB(o[1]=__builtin_amdgcn_mfma_f32_32x32x16_bf16(PAF(2),VFR(6),o[1],0,0,0), C1,4); \
    GAPB(o[0]=__builtin_amdgcn_mfma_f32_32x32x16_bf16(PAF(3),VFR(3),o[0],0,0,0), C1,8); \
    GAPB(o[1]=__builtin_amdgcn_mfma_f32_32x32x16_bf16(PAF(3),VFR(7),o[1],0,0,0), C1,12); \
    }while(0)
  int t=1;
  #undef CMASK
  #define CMASK(P0,P1,t) do{ if((t)<4)cmask(P0,P1,(t),qrel,hi);}while(0)
  for(;t+5<NT;t+=2){
    STEP(pB0,pB1,pA0,pA1,t,true,true,true);     WAIT_BAR(2); RESC(); ROT();
    STEP(pA0,pA1,pB0,pB1,t+1,true,true,true);   WAIT_BAR(2); RESC(); ROT();
  }
  #undef CMASK
  #define CMASK(P0,P1,t) do{ if((t)<4)cmask(P0,P1,(t),qrel,hi);}while(0)
  #define ENDW(tt) do{ if((tt)+3<NT){WAIT_BAR(2);} else if((tt)+2<NT){WAIT_BAR(1);} else {WAIT_BAR(0);} }while(0)
  for(;t+1<NT;t+=2){
    STEP(pB0,pB1,pA0,pA1,t,(t+3<NT),(t+1<NT),(t+1<NT));       ENDW(t);   RESC(); ROT();
    STEP(pA0,pA1,pB0,pB1,t+1,(t+4<NT),(t+2<NT),(t+2<NT));     ENDW(t+1); RESC(); ROT();
  }
  STEP(pB0,pB1,pA0,pA1,NT-1,false,false,false); RESC();
  { float sacc=pB0[0]+pB0[1]; _Pragma("unroll") for(int r=2;r<16;++r)sacc+=pB0[r]; _Pragma("unroll") for(int r=0;r<16;++r)sacc+=pB1[r]; l_reg+=sacc;
    pw0=(u32x4){PKW(pB0,0),PKW(pB0,2),PKW(pB0,4),PKW(pB0,6)};pw1=(u32x4){PKW(pB0,8),PKW(pB0,10),PKW(pB0,12),PKW(pB0,14)};pw2=(u32x4){PKW(pB1,0),PKW(pB1,2),PKW(pB1,4),PKW(pB1,6)};pw3=(u32x4){PKW(pB1,8),PKW(pB1,10),PKW(pB1,12),PKW(pB1,14)};
    SBAR(); pv(o,vb0+sl_cur,PAF(0),PAF(1),PAF(2),PAF(3)); }
  #undef PKW
  #undef PAF
  #undef VFR
  #undef PIN
  #undef MX3
  #undef GAPA
  #undef GAPB
  #undef EX
  #undef VRD
  #undef KRD
  #undef STEP
  #undef ENDW
  {auto rr=__builtin_amdgcn_permlane32_swap(__float_as_uint(l_reg),__float_as_uint(l_reg),false,false);l_reg=__uint_as_float(rr[0])+__uint_as_float(rr[1]);}
  int hi_e=hi,r32_e=r32; asm volatile("":"+v"(hi_e),"+v"(r32_e));
  if(hi_e==0)wsf[32+r32_e]=l_reg;asm volatile("s_waitcnt lgkmcnt(0)":::"memory");
  float rli[16];
  #pragma unroll
  for(int r=0;r<16;++r)rli[r]=__builtin_amdgcn_rcpf(wsf[32+crow(r,hi_e)]);
  const long grow0=rowbase+q0+wid*QBLK;
  { bf16*stg=(bf16*)(shm+LDS_OST)+wid*2048;
    #pragma unroll
    for(int r=0;r<16;++r){const int orow=crow(r,hi_e);
      #pragma unroll
      for(int d0=0;d0<2;++d0)stg[orow*64+d0*32+r32_e]=__float2bfloat16(o[d0][r]*rli[r]);}
    asm volatile("s_waitcnt lgkmcnt(0)":::"memory");
    #pragma unroll
    for(int i=0;i<4;++i){int lane_e=lane; asm volatile("":"+v"(lane_e)); const int row=i*8+(lane_e>>3),ch=lane_e&7; const bf16x8 v=*(const bf16x8*)(stg+row*64+ch*8); const long grow=grow0+row;
      const bf16x8 gv=*(const bf16x8*)(G+grow*DM+h*D+ch*8); float yv[8]; float ss=0.f;
      #pragma unroll
      for(int e=0;e<8;++e){const float ov=bf2f(v[e]); ss+=ov*ov; yv[e]=ov*bf2f(gv[e]);}
      ss+=__shfl_xor(ss,1); ss+=__shfl_xor(ss,2); ss+=__shfl_xor(ss,4);
      u32x4 w; w.x=cvtpk_s(yv[0],yv[1]); w.y=cvtpk_s(yv[2],yv[3]); w.z=cvtpk_s(yv[4],yv[5]); w.w=cvtpk_s(yv[6],yv[7]);
      ATTN_STORE16(Y+grow*1024+h*D+ch*8,w); if(ch==0)ssA[grow*8+h]=ss; } }
  asm volatile("s_waitcnt lgkmcnt(0)\n\ts_barrier":::"memory");
  #undef DMA_K
  #undef PHYS
  #undef DMA_V
  #undef CMASK
  #undef START
  #undef RESC
  #undef ROT
}
constexpr int ATTN_LDS_BYTES=LDS_BYTES;
struct AttnTensors { const bf16* Q; const bf16* K; const bf16* V; const bf16* G; bf16* Y; float* ssA; const float* kms; };
struct AttnUnit { int bh; int qb; };
struct StaticOrder {
  int vcu;
  __device__ __forceinline__ explicit StaticOrder(int v):vcu(v){}
  __device__ __forceinline__ bool next(int i,AttnUnit&u)const{ if(i>=8)return false; u.bh=vcu; u.qb=7-i; return true; }
  __device__ __forceinline__ void a_ready(const AttnUnit&)const{}
  __device__ __forceinline__ void done(const AttnUnit&)const{}
};
template<class Sched,int THRL=8> __device__ __forceinline__ void attn_phase(char*lds,const AttnTensors&T,const Sched&S){
  AttnUnit u;
  for(int i=0;S.next(i,u);++i){ S.a_ready(u); attn_unit<THRL>(u.bh/NHEAD,u.bh%NHEAD,u.qb,T.Q,T.K,T.V,T.G,T.Y,T.ssA,T.kms,lds); S.done(u); }
}
#undef SBAR
#undef WAIT_BAR
}
#define LAS __attribute__((address_space(3)))
typedef unsigned short bf16;
typedef unsigned v4u __attribute__((ext_vector_type(4)));
typedef float f32x4 __attribute__((ext_vector_type(4)));
typedef short bf16x8 __attribute__((ext_vector_type(8)));
constexpr int NWAVES = 8;
constexpr int NB = 32, SEQL = 2048, DMODEL = 1024, MROWS = NB * SEQL, NIN = 3072, AW = 512;
constexpr float EPSN = 1e-6f;
constexpr size_t MiB = 1u << 20;
constexpr size_t WS_KMS = 0, CTL_ZERO_BYTES = 1 * MiB;
constexpr size_t WS_WIN = 2 * MiB, WS_WOUT = 8 * MiB, WS_MOD = 10 * MiB, WS_ROPE = 11 * MiB, WS_SSA = 12 * MiB, WS_SSL = 14 * MiB, WS_SSX = 16 * MiB;
constexpr size_t WS_XN = 32 * MiB;
constexpr size_t WS_SEC = 160 * MiB, SEC_BYTES = 64 * MiB;
constexpr size_t WS_END = WS_SEC + 6 * SEC_BYTES;
constexpr int RING_BYTES = 131072, LDS_BYTES = 147456;

__device__ __forceinline__ unsigned f2bf(float f) { unsigned u = __builtin_bit_cast(unsigned, f); return (u + 0x7fffu + ((u >> 16) & 1u)) >> 16; }
__device__ __forceinline__ unsigned pk2(float lo, float hi) { return f2bf(lo) | (f2bf(hi) << 16); }
__device__ __forceinline__ float bfu2f(unsigned short v) { return __uint_as_float(((unsigned)v) << 16); }
__device__ __forceinline__ float wave_sum(float v) {
#pragma unroll
    for (int o = 1; o < 64; o <<= 1) v += __shfl_xor(v, o);
    return v;
}
__device__ __forceinline__ void p0_transpose_item(const float* W, int K, int N, bf16* WT, bool qkperm, LAS float* scr, int item, int lane) {
    const int nblk = N / 32, kb = item / nblk, nb = item % nblk, k0 = 64 * kb, n0 = 32 * nb;
#pragma unroll 8
    for (int i = 0; i < 32; ++i) { const int kk = 2 * i + (lane >> 5); scr[kk * 33 + (lane & 31)] = W[(size_t)(k0 + kk) * N + n0 + (lane & 31)]; }
    asm volatile("s_waitcnt lgkmcnt(0)" ::: "memory");
    const int c = lane & 7;
#pragma unroll
    for (int j = 0; j < 4; ++j) { const int n = (lane >> 3) + 8 * j; const LAS float* s = scr + (8 * c) * 33 + n;
        v4u o; o.x = pk2(s[0 * 33], s[1 * 33]); o.y = pk2(s[2 * 33], s[3 * 33]); o.z = pk2(s[4 * 33], s[5 * 33]); o.w = pk2(s[6 * 33], s[7 * 33]);
        int nsrc = n0 + n, ndst = nsrc;
        if (qkperm && nsrc < 1024) { const int d = nsrc & 63; ndst = (nsrc & ~63) + 32 * ((d >> 4) & 1) + 8 * ((d >> 2) & 3) + 4 * (d >> 5) + (d & 3); }
        *(v4u*)(WT + (size_t)ndst * K + k0 + 8 * c) = o; }
    asm volatile("s_waitcnt lgkmcnt(0)" ::: "memory");
}

namespace lru_body {
constexpr int T = 64;
constexpr int XS_OFF = 0, XCF_OFF = 17408, XCB_OFF = XCF_OFF + 16384, A_OFF = XCB_OFF + 9216, U_OFF = A_OFF + 16384, CAR_OFF = U_OFF + 16384, LRU_LDS = CAR_OFF + 4096;
static_assert(LRU_LDS <= RING_BYTES, "lru lds");
__device__ __forceinline__ void lru_unit(LAS unsigned char* lds, int b, int g, const bf16* XL, const bf16* ZL, bf16* Y, float* ssL,
                                         const float* conv_w, const float* conv_b, const float* w_r, const float* b_r, const float* w_i, const float* b_i, const float* lam) {
    int tid_l = threadIdx.x; asm volatile("" : "+v"(tid_l));
    const int tid = tid_l, lane = tid & 63, wid = __builtin_amdgcn_readfirstlane(tid >> 6);
    LAS float* XS = (LAS float*)(lds + XS_OFF); LAS float* XCF = (LAS float*)(lds + XCF_OFF); LAS unsigned short* XCB = (LAS unsigned short*)(lds + XCB_OFF);
    LAS float* AS = (LAS float*)(lds + A_OFF); LAS float* US = (LAS float*)(lds + U_OFF); LAS float* CAR = (LAS float*)(lds + CAR_OFF);
    const int ct = tid >> 3, cc8 = (tid & 7) * 8;
    float cw[4][8], cb[8];
#pragma unroll
    for (int e = 0; e < 8; ++e) { cb[e] = conv_b[g * 64 + cc8 + e];
#pragma unroll
        for (int j = 0; j < 4; ++j) cw[j][e] = conv_w[j * 512 + g * 64 + cc8 + e]; }
    const int fr = lane & 15, fq = lane >> 4, cgp = wid & 3, rh = wid >> 2;
    bf16x8 wrf[2], wif[2];
#pragma unroll
    for (int ks = 0; ks < 2; ++ks)
#pragma unroll
        for (int j = 0; j < 8; ++j) { const size_t wi = ((size_t)g * 64 + 32 * ks + 8 * fq + j) * 64 + 16 * cgp + fr;
            wrf[ks][j] = (short)f2bf(w_r[wi]); wif[ks][j] = (short)f2bf(w_i[wi]); }
    const int ch0 = 16 * cgp + 4 * fq;
    float brr[4], bii[4], spc[4];
#pragma unroll
    for (int r = 0; r < 4; ++r) { brr[r] = b_r[g * 64 + ch0 + r]; bii[r] = b_i[g * 64 + ch0 + r]; spc[r] = -8.0f * log1pf(expf(-lam[g * 64 + ch0 + r])); }
    const int sch = lane, sub = wid;
    float hc = 0.f;
    const size_t rowb = (size_t)b * SEQL;
    const int lr = tid >> 3, lc8 = (tid & 7) * 8;
    v4u px0, px1 = (v4u){0u, 0u, 0u, 0u};
    { const int tok = lr - 3; px0 = (v4u){0u, 0u, 0u, 0u}; if (tok >= 0) px0 = *(const v4u*)(XL + (rowb + tok) * 512 + g * 64 + lc8);
      if (tid < 24) px1 = *(const v4u*)(XL + (rowb + 61 + lr) * 512 + g * 64 + lc8); }
    for (int c = 0; c < SEQL / T; ++c) {
        const int t0 = c * T;
        { LAS float* d = XS + lr * 64 + lc8;
          d[0] = bfu2f(px0.x & 0xffff); d[1] = bfu2f(px0.x >> 16); d[2] = bfu2f(px0.y & 0xffff); d[3] = bfu2f(px0.y >> 16);
          d[4] = bfu2f(px0.z & 0xffff); d[5] = bfu2f(px0.z >> 16); d[6] = bfu2f(px0.w & 0xffff); d[7] = bfu2f(px0.w >> 16);
          if (tid < 24) { LAS float* d2 = XS + (64 + lr) * 64 + lc8;
            d2[0] = bfu2f(px1.x & 0xffff); d2[1] = bfu2f(px1.x >> 16); d2[2] = bfu2f(px1.y & 0xffff); d2[3] = bfu2f(px1.y >> 16);
            d2[4] = bfu2f(px1.z & 0xffff); d2[5] = bfu2f(px1.z >> 16); d2[6] = bfu2f(px1.w & 0xffff); d2[7] = bfu2f(px1.w >> 16); } }
        __syncthreads();
        if (c + 1 < SEQL / T) { const size_t tok = rowb + t0 + T - 3 + lr; px0 = *(const v4u*)(XL + tok * 512 + g * 64 + lc8);
            if (tid < 24) px1 = *(const v4u*)(XL + (tok + 64) * 512 + g * 64 + lc8); }
        const v4u pg = *(const v4u*)(ZL + (rowb + t0 + ct) * 512 + g * 64 + cc8);
        { float xc[8];
#pragma unroll
          for (int e = 0; e < 8; ++e) xc[e] = cb[e];
#pragma unroll
          for (int j = 0; j < 4; ++j) { const f32x4 a0 = *(const LAS f32x4*)(XS + (ct + j) * 64 + cc8), a1 = *(const LAS f32x4*)(XS + (ct + j) * 64 + cc8 + 4);
#pragma unroll
              for (int e = 0; e < 4; ++e) { xc[e] += cw[j][e] * a0[e]; xc[4 + e] += cw[j][4 + e] * a1[e]; } }
          *(LAS f32x4*)(XCF + ct * 64 + cc8) = (f32x4){xc[0], xc[1], xc[2], xc[3]}; *(LAS f32x4*)(XCF + ct * 64 + cc8 + 4) = (f32x4){xc[4], xc[5], xc[6], xc[7]};
          v4u o; o.x = pk2(xc[0], xc[1]); o.y = pk2(xc[2], xc[3]); o.z = pk2(xc[4], xc[5]); o.w = pk2(xc[6], xc[7]);
          *(LAS v4u*)(XCB + ct * 72 + cc8) = o; }
        __syncthreads();
#pragma unroll
        for (int tt = 0; tt < 2; ++tt) {
            const int tok = 32 * rh + 16 * tt + fr;
            f32x4 dr = (f32x4){0.f, 0.f, 0.f, 0.f}, di = (f32x4){0.f, 0.f, 0.f, 0.f};
#pragma unroll
            for (int ks = 0; ks < 2; ++ks) { const bf16x8 xf = *(const LAS bf16x8*)(XCB + tok * 72 + 32 * ks + 8 * fq);
                dr = __builtin_amdgcn_mfma_f32_16x16x32_bf16(wrf[ks], xf, dr, 0, 0, 0); di = __builtin_amdgcn_mfma_f32_16x16x32_bf16(wif[ks], xf, di, 0, 0, 0); }
            const f32x4 xv = *(const LAS f32x4*)(XCF + tok * 64 + ch0);
            f32x4 av, uv;
#pragma unroll
            for (int r = 0; r < 4; ++r) { const float rg = 1.0f / (1.0f + __expf(-(dr[r] + brr[r]))), ig = 1.0f / (1.0f + __expf(-(di[r] + bii[r])));
                const float la = rg * spc[r]; av[r] = __expf(la); uv[r] = sqrtf(-expm1f(2.0f * la)) * ig * xv[r]; }
            *(LAS f32x4*)(AS + tok * 64 + ch0) = av; *(LAS f32x4*)(US + tok * 64 + ch0) = uv;
        }
        __syncthreads();
        float a8[8], u8[8]; float P = 1.f, H = 0.f;
#pragma unroll
        for (int i = 0; i < 8; ++i) { a8[i] = AS[(8 * sub + i) * 64 + sch]; u8[i] = US[(8 * sub + i) * 64 + sch]; H = a8[i] * H + u8[i]; P *= a8[i]; }
        CAR[sub * 64 + sch] = P; CAR[512 + sub * 64 + sch] = H;
        __syncthreads();
        { float h = hc, hin = hc;
#pragma unroll
          for (int s = 0; s < 8; ++s) { const float Ps = CAR[s * 64 + sch], Hs = CAR[512 + s * 64 + sch]; if (s == sub) hin = h; h = Ps * h + Hs; }
          hc = h; h = hin;
#pragma unroll
          for (int i = 0; i < 8; ++i) { h = a8[i] * h + u8[i]; US[(8 * sub + i) * 64 + sch] = h; } }
        __syncthreads();
        { const f32x4 r0 = *(const LAS f32x4*)(US + ct * 64 + cc8), r1 = *(const LAS f32x4*)(US + ct * 64 + cc8 + 4);
          float ss = (r0[0] * r0[0] + r0[1] * r0[1]) + (r0[2] * r0[2] + r0[3] * r0[3]) + (r1[0] * r1[0] + r1[1] * r1[1]) + (r1[2] * r1[2] + r1[3] * r1[3]);
          ss += __shfl_xor(ss, 1); ss += __shfl_xor(ss, 2); ss += __shfl_xor(ss, 4);
          v4u o; o.x = pk2(r0[0] * bfu2f(pg.x & 0xffff), r0[1] * bfu2f(pg.x >> 16)); o.y = pk2(r0[2] * bfu2f(pg.y & 0xffff), r0[3] * bfu2f(pg.y >> 16));
          o.z = pk2(r1[0] * bfu2f(pg.z & 0xffff), r1[1] * bfu2f(pg.z >> 16)); o.w = pk2(r1[2] * bfu2f(pg.w & 0xffff), r1[3] * bfu2f(pg.w >> 16));
          const size_t row = rowb + t0 + ct;
          *(v4u*)(Y + row * 1024 + 512 + g * 64 + cc8) = o;
          if ((tid & 7) == 0) ssL[row * 8 + g] = ss; }
    }
    __syncthreads();
}
}

struct Args { const float* in[17]; float* out; unsigned char* ws; };
__global__ void __launch_bounds__(NWAVES * 64, 2) hymba_fwd(Args args) {
    extern __shared__ __attribute__((aligned(16))) unsigned char lds_raw[];
    cg::grid_group grid = cg::this_grid();
    LAS unsigned char* lds = (LAS unsigned char*)lds_raw;
    const int tid = threadIdx.x, lane = tid & 63, wave = __builtin_amdgcn_readfirstlane(tid >> 6);
    const int G = gridDim.x, bx = blockIdx.x;
    unsigned char* ws = args.ws;
    const float* x = args.in[0]; const float* cin = args.in[1]; const float* w_mod = args.in[2]; const float* b_mod = args.in[3]; const float* norm_gain = args.in[4];
    const float* w_in = args.in[5]; const float* conv_w = args.in[6]; const float* conv_b = args.in[7]; const float* w_rg = args.in[8]; const float* b_rg = args.in[9];
    const float* w_ig = args.in[10]; const float* b_ig = args.in[11]; const float* lam = args.in[12]; const float* gA = args.in[13]; const float* gL = args.in[14];
    const float* w_out = args.in[15]; const float* final_gain = args.in[16];
    float* out = args.out;
    float* KMS = (float*)(ws + WS_KMS); bf16* WIN = (bf16*)(ws + WS_WIN); bf16* WOUT = (bf16*)(ws + WS_WOUT); float* MOD = (float*)(ws + WS_MOD);
    float* ROPEC = (float*)(ws + WS_ROPE); float* ROPES = ROPEC + 2048 * 32; float* SSA = (float*)(ws + WS_SSA); float* SSL = (float*)(ws + WS_SSL); float* SSX = (float*)(ws + WS_SSX);
    bf16* XN = (bf16*)(ws + WS_XN); bf16* Y = XN; bf16* SEC = (bf16*)(ws + WS_SEC);
    bf16* QB_ = SEC; bf16* KB_ = SEC + 1 * (SEC_BYTES / 2); bf16* VB_ = SEC + 2 * (SEC_BYTES / 2); bf16* ZA_ = SEC + 3 * (SEC_BYTES / 2); bf16* XL_ = SEC + 4 * (SEC_BYTES / 2); bf16* ZL_ = SEC + 5 * (SEC_BYTES / 2);
    const int gw = bx * NWAVES + wave, NGW = G * NWAVES;

    {
        LAS float* scr = (LAS float*)(lds + wave * 16384);
        constexpr int I_IN = (DMODEL / 64) * (NIN / 32), I_OUT = (DMODEL / 64) * (DMODEL / 32);
        for (int it = gw; it < I_IN + I_OUT; it += NGW) {
            if (it < I_IN) p0_transpose_item(w_in, DMODEL, NIN, WIN, true, scr, it, lane);
            else p0_transpose_item(w_out, DMODEL, DMODEL, WOUT, false, scr, it - I_IN, lane);
        }
        for (int e = bx * 512 + tid; e < 2048 * 32; e += G * 512) {
            const int pos = e >> 5, i = e & 31;
            const float invf = (float)exp2(-(double)(2 * i) / 64.0 * 13.287712379549449);
            const float ang = (float)pos * invf;
            double a = (double)ang; const double n2 = rint(a * 0.15915494309189535); a = (a - n2 * 6.283185307179586) - n2 * 2.4492935982947064e-16;
            double a2 = a * a, sc = 1.0, cc = 1.0, ts = 1.0, tc = 1.0;
            for (int k = 1; k <= 15; ++k) { tc = -tc * a2 / (double)((2 * k - 1) * (2 * k)); ts = -ts * a2 / (double)((2 * k) * (2 * k + 1)); cc += tc; sc += ts; }
            ROPEC[e] = (float)cc; ROPES[e] = (float)(sc * a);
        }
        __syncthreads();
        if (bx < 48) {
            LAS float* cs = (LAS float*)lds;
            for (int idx = tid; idx < 32768; idx += 512) { const int bb = idx >> 10, k = idx & 1023; const float v = cin[idx]; cs[k * 32 + bb] = v / (1.0f + expf(-v)); }
            __syncthreads();
            const int n = bx * 64 + lane;
            float acc[32];
#pragma unroll
            for (int i = 0; i < 32; ++i) acc[i] = 0.f;
            for (int k = wave * 128; k < wave * 128 + 128; ++k) {
                const float w = w_mod[(size_t)k * 3072 + n];
#pragma unroll
                for (int b4 = 0; b4 < 8; ++b4) { const f32x4 cv = *(const LAS f32x4*)(cs + k * 32 + 4 * b4);
                    acc[4 * b4 + 0] += w * cv[0]; acc[4 * b4 + 1] += w * cv[1]; acc[4 * b4 + 2] += w * cv[2]; acc[4 * b4 + 3] += w * cv[3]; }
            }
            __syncthreads();
            LAS float* red = (LAS float*)lds;
#pragma unroll
            for (int i = 0; i < 32; ++i) red[(wave * 32 + i) * 64 + lane] = acc[i];
            __syncthreads();
            for (int o = tid; o < 2048; o += 512) { const int bb = o >> 6, col = o & 63; float s = b_mod[bx * 64 + col];
#pragma unroll
                for (int kg = 0; kg < 8; ++kg) s += red[(kg * 32 + bb) * 64 + col];
                MOD[bb * 3072 + bx * 64 + col] = s; }
            __syncthreads();
        }
    }
    grid.sync();
    for (int gwi = gw; gwi < MROWS / 32; gwi += NGW) {
        const int bb = gwi >> 6;
        f32x4 ca[4], cbv[4];
#pragma unroll
        for (int j = 0; j < 4; ++j) { const int col = 4 * lane + 256 * j; const f32x4 gn = *(const f32x4*)(norm_gain + col), sc = *(const f32x4*)(MOD + bb * 3072 + 1024 + col);
            ca[j] = gn * (sc + 1.0f); cbv[j] = *(const f32x4*)(MOD + bb * 3072 + col); }
        for (int r = 0; r < 32; ++r) {
            const size_t row = (size_t)gwi * 32 + r; const f32x4* xr = (const f32x4*)(x + row * 1024) + lane;
            f32x4 v[4]; float s = 0.f;
#pragma unroll
            for (int j = 0; j < 4; ++j) { v[j] = xr[64 * j]; s += (v[j][0] * v[j][0] + v[j][1] * v[j][1]) + (v[j][2] * v[j][2] + v[j][3] * v[j][3]); }
            const float rinv = 1.0f / sqrtf(wave_sum(s) * (1.0f / 1024.0f) + EPSN);
            unsigned long long* o8 = (unsigned long long*)(XN + row * 1024) + lane;
#pragma unroll
            for (int j = 0; j < 4; ++j) { const f32x4 hh = v[j] * rinv * ca[j] + cbv[j];
                o8[64 * j] = (unsigned long long)pk2(hh[0], hh[1]) | ((unsigned long long)pk2(hh[2], hh[3]) << 32); }
        }
    }
    grid.sync();
    {
        pg8::Gemm g{XN, WIN, MROWS, NIN, DMODEL}; pg8::StaticOrder S; S.init(MROWS, NIN, G, bx);
        pg8::EpiIn E{SEC, SEC_BYTES / 2, ROPEC, ROPES, KMS, gA, gL};
#ifndef SKIP_P1
        pg8::gemm_phase<pg8::EpiIn, pg8::StaticOrder, PG8_ALIGN, PG8_SP2>(lds, g, S, E);
#endif
    }
    grid.sync();
    {
        const int vcu = (G % 8 == 0) ? (bx % 8) * (G / 8) + bx / 8 : bx;
        for (int uu = vcu; uu < 256; uu += G) {
#ifndef SKIP_LRU
            lru_body::lru_unit(lds, uu >> 3, uu & 7, XL_, ZL_, Y, SSL, conv_w, conv_b, w_rg, b_rg, w_ig, b_ig, lam);
#endif
        }
        const attn_body::AttnTensors AT{(const attn_body::bf16*)QB_, (const attn_body::bf16*)KB_, (const attn_body::bf16*)VB_, (const attn_body::bf16*)ZA_, (attn_body::bf16*)Y, SSA, KMS};
        for (int uu = vcu; uu < 256; uu += G) {
            const attn_body::StaticOrder S(uu);
#ifndef SKIP_ATT
            attn_body::attn_phase<attn_body::StaticOrder>((char*)lds_raw, AT, S);
#endif
        }
    }
    grid.sync();
    {
        pg8::Gemm g{Y, WOUT, MROWS, DMODEL, DMODEL}; pg8::StaticOrder S; S.init(MROWS, DMODEL, G, bx);
        pg8::EpiOut E{x, out, MOD + 2048, SSA, SSL, SSX};
#ifndef SKIP_P3
        pg8::gemm_phase<pg8::EpiOut, pg8::StaticOrder, PG8_ALIGN, PG8_SP2>(lds, g, S, E);
#endif
    }
    grid.sync();
    for (int gwi = gw; gwi < MROWS / 32; gwi += NGW) {
        f32x4 fg[4];
#pragma unroll
        for (int j = 0; j < 4; ++j) fg[j] = *(const f32x4*)(final_gain + 4 * lane + 256 * j);
        for (int r = 0; r < 32; ++r) {
            const size_t row = (size_t)gwi * 32 + r; f32x4* xr = (f32x4*)(out + row * 1024) + lane;
            const f32x4* sp = (const f32x4*)(SSX + row * 16); const f32x4 s0 = sp[0], s1 = sp[1], s2 = sp[2], s3 = sp[3];
            const float ss = (((s0[0] + s0[1]) + (s0[2] + s0[3])) + ((s1[0] + s1[1]) + (s1[2] + s1[3]))) + (((s2[0] + s2[1]) + (s2[2] + s2[3])) + ((s3[0] + s3[1]) + (s3[2] + s3[3])));
            const float rinv = 1.0f / sqrtf(ss * (1.0f / 1024.0f) + EPSN);
#pragma unroll
            for (int j = 0; j < 4; ++j) { const f32x4 v = xr[64 * j]; xr[64 * j] = v * rinv * fg[j]; }
        }
    }
}

extern "C" void kernel_launch(void* const* d_in, const int* in_sizes, int n_in, void* d_out, int out_size, void* d_ws, size_t ws_size, hipStream_t stream) {
    static int grid = 0;
    if (grid == 0) {
        if (n_in != 17 || out_size != MROWS * DMODEL || ws_size < WS_END) { fprintf(stderr, "kernel_launch: unexpected shapes (n_in %d out %d ws %zu)\n", n_in, out_size, ws_size); grid = -1; return; }
        int dev = 0, cus = 0, per_cu = 0;
        if (hipGetDevice(&dev) != hipSuccess || hipDeviceGetAttribute(&cus, hipDeviceAttributeMultiprocessorCount, dev) != hipSuccess) { grid = -1; return; }
        if (hipFuncSetAttribute((const void*)hymba_fwd, hipFuncAttributeMaxDynamicSharedMemorySize, LDS_BYTES) != hipSuccess) { fprintf(stderr, "kernel_launch: hipFuncSetAttribute failed\n"); grid = -1; return; }
        if (hipOccupancyMaxActiveBlocksPerMultiprocessor(&per_cu, (const void*)hymba_fwd, NWAVES * 64, LDS_BYTES) != hipSuccess || per_cu < 1) { fprintf(stderr, "kernel_launch: occupancy query says %d\n", per_cu); per_cu = 1; }
        (void)hipGetLastError();
        grid = cus;
        if (grid > 256) grid = 256;
    }
    if (grid < 0) return;
    (void)hipMemsetAsync((char*)d_ws + WS_KMS, 0, CTL_ZERO_BYTES, stream);
    Args a{};
    for (int i = 0; i < 17; ++i) a.in[i] = (const float*)d_in[i];
    a.out = (float*)d_out; a.ws = (unsigned char*)d_ws;
    void* params[] = {&a};
    hipError_t e = hipLaunchCooperativeKernel((const void*)hymba_fwd, dim3(grid), dim3(NWAVES * 64), params, LDS_BYTES, stream);
    if (e != hipSuccess) fprintf(stderr, "kernel_launch: cooperative launch failed: %s (grid %d)\n", hipGetErrorString(e), grid);
}
```

```cpp
#include <hip/hip_runtime.h>
#include <hip/hip_cooperative_groups.h>
#include <hip/hip_bf16.h>
#include <cstdio>
#include <cstdint>
#include <cmath>
namespace cg = cooperative_groups;
namespace pg8 {
#define PG8_LAS __attribute__((address_space(3)))
typedef unsigned short bf16_t;
typedef short bf16x8 __attribute__((ext_vector_type(8)));
typedef float f32x4 __attribute__((ext_vector_type(4)));
typedef unsigned u32x4 __attribute__((ext_vector_type(4)));
constexpr int BM = 256, BK = 64, HALF = 128, HTB = HALF * BK * 2  , STAGE_BYTES = 8 * HTB, NXCD = 8, WGM = 8;

__host__ __device__ __forceinline__ int lds_byte(int r, int c) { const int st = (r >> 4) * 2 + (c >> 5), rr = r & 15, cc = c & 31, ob = rr * 64 + cc * 2; return st * 1024 + (ob ^ (((ob >> 9) & 1) << 5)); }
__host__ __device__ __forceinline__ void stage_rc(int b, int& R, int& C) { const int st = b / 1024, sb = b % 1024, swz = sb ^ (((sb >> 9) & 1) << 5); R = (st >> 1) * 16 + swz / 64; C = (st & 1) * 32 + (swz % 64) / 2; }
__host__ __device__ __forceinline__ int perm32(int rho) { const int n = rho >> 4, i = rho & 15; return 8 * (i >> 2) + 4 * n + (i & 3); }

struct Unit { int pm, pn; };
struct Gemm { const bf16_t* A; const bf16_t* Bt; int M, N, K; };

struct StaticOrder {
    int nM, nN, nwg, G, c;
    __host__ __device__ void init(int M, int N, int G_, int c_) { nM = M / BM; nN = N / BM; nwg = nM * nN; G = G_; c = c_; }
    __host__ __device__ bool next(int i, Unit& u) const {
        const long L = (long)i * G + c; if (L >= nwg) return false;
        int wgid = (int)L; { const int q = nwg / NXCD, r = nwg % NXCD, xcd = wgid % NXCD, off = wgid / NXCD; wgid = (xcd < r ? xcd * (q + 1) : r * (q + 1) + (xcd - r) * q) + off; }
        const int nig = WGM * nN, gid = wgid / nig, fm = gid * WGM, gsz = (nM - fm) < WGM ? (nM - fm) : WGM;
        u.pm = fm + ((wgid % nig) % gsz); u.pn = (wgid % nig) / gsz; return true;
    }
    __device__ __forceinline__ void a_ready(const Unit&) const {}
    __device__ __forceinline__ void done(const Unit&) const {}
};

__device__ __forceinline__ unsigned cvt_pk_bf16(float lo, float hi) { unsigned r; asm volatile("v_cvt_pk_bf16_f32 %0, %1, %2" : "=v"(r) : "v"(lo), "v"(hi)); return r; }
typedef float f32x2 __attribute__((ext_vector_type(2)));
constexpr float QK_C2 = 0.125f * 1.4426950408889634f;
__device__ __forceinline__ float silu_f(float z) { return z * __builtin_amdgcn_rcpf(1.0f + __builtin_amdgcn_exp2f(-1.4426950408889634f * z)); }
struct EpiIn {
    static constexpr bool PERM = true, AFTER_DRAIN = false, MIDSCALE = false;
    bf16_t* O; size_t sec_stride; const float* ropec; const float* ropes; float* kms; const float* gA; const float* gL;
    __device__ __forceinline__ void mid(f32x4 (&)[2][2][4][2], const Unit&, int, int) const {}
    __device__ __forceinline__ void operator()(const f32x4 (&acc)[2][2][4][2], const Unit& u, int wr, int wc, int fr, int fq) const {
        const int sec = u.pn >> 1, colt = (u.pn & 1) * 256;
        bf16_t* base = O + (size_t)sec * sec_stride;
        const int row0 = u.pm * BM + wr * 64 + fr, col0 = colt + wc * 32 + 8 * fq;
        if (sec <= 1) {
            const float sc = (sec == 0) ? QK_C2 : 1.0f;
            const int dd = 16 * (wc & 1) + 4 * fq;
            f32x4 ks[2][2];
#pragma unroll
            for (int bj = 0; bj < 2; ++bj) { ks[bj][0] = (f32x4){0.f, 0.f, 0.f, 0.f}; ks[bj][1] = (f32x4){0.f, 0.f, 0.f, 0.f}; }
#pragma unroll
            for (int ai = 0; ai < 2; ++ai)
#pragma unroll
                for (int m = 0; m < 4; ++m) {
                    const int row = row0 + ai * HALF + m * 16, pos = row & 2047;
                    const f32x4 cv = *(const f32x4*)(ropec + pos * 32 + dd), sv = *(const f32x4*)(ropes + pos * 32 + dd);
                    bf16_t* rowp = base + (size_t)row * 512 + col0;
#pragma unroll
                    for (int bj = 0; bj < 2; ++bj) {
                        const f32x4 t1 = acc[ai][bj][m][0], t2 = acc[ai][bj][m][1];
                        f32x4 o1 = t1 * cv - t2 * sv, o2 = t2 * cv + t1 * sv;
                        ks[bj][0] += o1; ks[bj][1] += o2;
                        o1 = o1 * sc; o2 = o2 * sc;
                        u32x4 w; w.x = cvt_pk_bf16(o1[0], o1[1]); w.y = cvt_pk_bf16(o1[2], o1[3]); w.z = cvt_pk_bf16(o2[0], o2[1]); w.w = cvt_pk_bf16(o2[2], o2[3]);
                        *(u32x4*)(rowp + bj * HALF) = w;
                    }
                }
            if (sec == 1) {
#pragma unroll
                for (int bj = 0; bj < 2; ++bj)
#pragma unroll
                    for (int n = 0; n < 2; ++n)
#pragma unroll
                        for (int i = 0; i < 4; ++i) {
                            float v = ks[bj][n][i];
                            v += __shfl_xor(v, 1); v += __shfl_xor(v, 2); v += __shfl_xor(v, 4); v += __shfl_xor(v, 8);
                            if (fr == 0) atomicAdd(kms + (size_t)u.pm * 512 + col0 + bj * HALF + 4 * n + i, v);
                        }
            }
        } else if (sec == 2 || sec == 4) {
#pragma unroll
            for (int ai = 0; ai < 2; ++ai)
#pragma unroll
                for (int m = 0; m < 4; ++m) {
                    bf16_t* rowp = base + (size_t)(row0 + ai * HALF + m * 16) * 512 + col0;
#pragma unroll
                    for (int bj = 0; bj < 2; ++bj) {
                        const f32x4 v0 = acc[ai][bj][m][0], v1 = acc[ai][bj][m][1];
                        u32x4 w; w.x = cvt_pk_bf16(v0[0], v0[1]); w.y = cvt_pk_bf16(v0[2], v0[3]); w.z = cvt_pk_bf16(v1[0], v1[1]); w.w = cvt_pk_bf16(v1[2], v1[3]);
                        *(u32x4*)(rowp + bj * HALF) = w;
                    }
                }
        } else {
            const float* gp = (sec == 3) ? gA : gL;
            f32x4 gv[2][2];
#pragma unroll
            for (int bj = 0; bj < 2; ++bj)
#pragma unroll
                for (int n = 0; n < 2; ++n) gv[bj][n] = *(const f32x4*)(gp + col0 + bj * HALF + 4 * n);
#pragma unroll
            for (int ai = 0; ai < 2; ++ai)
#pragma unroll
                for (int m = 0; m < 4; ++m) {
                    bf16_t* rowp = base + (size_t)(row0 + ai * HALF + m * 16) * 512 + col0;
#pragma unroll
                    for (int bj = 0; bj < 2; ++bj) {
                        f32x4 v0 = acc[ai][bj][m][0], v1 = acc[ai][bj][m][1];
#pragma unroll
                        for (int i = 0; i < 4; ++i) { v0[i] = silu_f(v0[i]) * gv[bj][0][i]; v1[i] = silu_f(v1[i]) * gv[bj][1][i]; }
                        u32x4 w; w.x = cvt_pk_bf16(v0[0], v0[1]); w.y = cvt_pk_bf16(v0[2], v0[3]); w.z = cvt_pk_bf16(v1[0], v1[1]); w.w = cvt_pk_bf16(v1[2], v1[3]);
                        *(u32x4*)(rowp + bj * HALF) = w;
                    }
                }
        }
    }
};
struct EpiOut {
    static constexpr bool PERM = false, AFTER_DRAIN = false, MIDSCALE = true;
    const float* x; float* out; const float* gate; const float* ssA; const float* ssL; float* ssx;
    __device__ __forceinline__ void scales(int row, float& ra, float& rl) const {
        const f32x4* pa = (const f32x4*)(ssA + (size_t)row * 8); const f32x4* pl = (const f32x4*)(ssL + (size_t)row * 8);
        const f32x4 a0 = pa[0], a1 = pa[1], l0 = pl[0], l1 = pl[1];
        const float sa = ((a0[0] + a0[1]) + (a0[2] + a0[3])) + ((a1[0] + a1[1]) + (a1[2] + a1[3]));
        const float sl = ((l0[0] + l0[1]) + (l0[2] + l0[3])) + ((l1[0] + l1[1]) + (l1[2] + l1[3]));
        ra = 1.0f / sqrtf(sa * (1.0f / 512.0f) + 1e-6f); rl = 1.0f / sqrtf(sl * (1.0f / 512.0f) + 1e-6f);
    }
    __device__ __forceinline__ void mid(f32x4 (&acc)[2][2][4][2], const Unit& u, int wr, int fr) const {
        asm volatile("" : "+v"(fr));
#pragma unroll
        for (int ai = 0; ai < 2; ++ai)
#pragma unroll
            for (int m = 0; m < 4; ++m) {
                float ra, rl; scales(u.pm * BM + ai * HALF + wr * 64 + m * 16 + fr, ra, rl);
                const float f = ra / rl;
#pragma unroll
                for (int bj = 0; bj < 2; ++bj)
#pragma unroll
                    for (int n = 0; n < 2; ++n) acc[ai][bj][m][n] = acc[ai][bj][m][n] * f;
                asm volatile("" ::: "memory");
            }
    }
    __device__ __forceinline__ void operator()(const f32x4 (&acc)[2][2][4][2], const Unit& u, int wr, int wc, int fr, int fq) const {
        asm volatile("" : "+v"(fr), "+v"(fq));
        const int col0 = u.pn * BM + wc * 32 + 4 * fq;
        const float* gp = gate + (size_t)(u.pm >> 3) * 3072 + col0;
        f32x4 gv[2][2];
#pragma unroll
        for (int bj = 0; bj < 2; ++bj)
#pragma unroll
            for (int n = 0; n < 2; ++n) gv[bj][n] = *(const f32x4*)(gp + bj * HALF + n * 16);
#pragma unroll
        for (int ai = 0; ai < 2; ++ai)
#pragma unroll
            for (int m = 0; m < 4; ++m) {
                const int row = u.pm * BM + ai * HALF + wr * 64 + m * 16 + fr;
                float ra, rl; scales(row, ra, rl);
                const size_t off = (size_t)row * 1024 + col0; float ss = 0.f;
#pragma unroll
                for (int bj = 0; bj < 2; ++bj)
#pragma unroll
                    for (int n = 0; n < 2; ++n) {
                        const f32x4 xv = *(const f32x4*)(x + off + bj * HALF + n * 16);
                        const f32x4 o = xv + gv[bj][n] * (acc[ai][bj][m][n] * rl);
                        ss += (o[0] * o[0] + o[1] * o[1]) + (o[2] * o[2] + o[3] * o[3]);
                        *(f32x4*)(out + off + bj * HALF + n * 16) = o;
                    }
                ss += __shfl_xor(ss, 16); ss += __shfl_xor(ss, 32);
                if (fq == 0) ssx[(size_t)row * 16 + u.pn * 4 + wc] = ss;
                asm volatile("" ::: "memory");
            }
    }
};

template <class Epi, class Sched, bool ALIGN_EPI = false, bool SP2 = false>
__device__ __forceinline__ void gemm_phase(PG8_LAS unsigned char* lds, const Gemm g, const Sched& S, const Epi& E) {
    int tid_l = threadIdx.x; asm volatile("" : "+v"(tid_l));
    const int tid = tid_l, wid = __builtin_amdgcn_readfirstlane(tid >> 6), lane = tid & 63, wr = wid >> 2, wc = wid & 3, fr = lane & 15, fq = lane >> 4;
    const int K = g.K, nt = K / BK;
    unsigned voffA[2], voffB[2];
#pragma unroll
    for (int i = 0; i < 2; ++i) { int R, C; stage_rc(tid * 16 + i * 8192, R, C); const int Rb = Epi::PERM ? ((R & ~31) + perm32(R & 31)) : R;
        voffA[i] = (unsigned)(R * K + C) * 2u; voffB[i] = (unsigned)(Rb * K + C) * 2u; }
    const size_t kstep = (size_t)(BK * 2);
    const size_t hstep = (size_t)HALF * K * 2;
    const size_t tstep = 2 * hstep;
    const unsigned ldsw = (unsigned)wid * 1024u;
    const int aoff = lds_byte(wr * 64 + fr, fq * 8), boff = lds_byte(wc * 32 + fr, fq * 8);
#define PG8_SA(b, h) (((b) * 2 + (h)) * HTB)
#define PG8_SB(b, h) ((4 + (b) * 2 + (h)) * HTB)
#define PG8_STAGE(bufoff, gbase, voff) do { _Pragma("unroll") for (int _i = 0; _i < 2; ++_i) \
        __builtin_amdgcn_global_load_lds((const unsigned*)((const char*)(gbase) + (voff)[_i]), (PG8_LAS unsigned*)(lds + (bufoff) + ldsw + _i * 8192), 16, 0, 0); } while (0)
#define PG8_LDA(dst, b, h) do { _Pragma("unroll") for (int m = 0; m < 4; ++m) _Pragma("unroll") for (int k = 0; k < 2; ++k) dst[m][k] = *(const PG8_LAS bf16x8*)(lds + PG8_SA(b, h) + aoff + m * 2048 + k * 1024); } while (0)
#define PG8_LDB(dst, b, h) do { _Pragma("unroll") for (int n = 0; n < 2; ++n) _Pragma("unroll") for (int k = 0; k < 2; ++k) dst[n][k] = *(const PG8_LAS bf16x8*)(lds + PG8_SB(b, h) + boff + n * 2048 + k * 1024); } while (0)
#define PG8_MMA(ai, bj, At, Bt) do { __builtin_amdgcn_s_setprio(1); _Pragma("unroll") for (int m = 0; m < 4; ++m) _Pragma("unroll") for (int n = 0; n < 2; ++n) _Pragma("unroll") for (int k = 0; k < 2; ++k) \
        acc[ai][bj][m][n] = __builtin_amdgcn_mfma_f32_16x16x32_bf16(Bt[n][k], At[m][k], acc[ai][bj][m][n], 0, 0, 0); __builtin_amdgcn_s_setprio(0); } while (0)
#define PG8_WAIT_V(n) asm volatile("s_waitcnt vmcnt(" #n ")" ::: "memory")
#define PG8_WAIT_L(n) asm volatile("s_waitcnt lgkmcnt(" #n ")" ::: "memory")
#define PG8_BAR __builtin_amdgcn_s_barrier()
#define PG8_SCHED __builtin_amdgcn_sched_barrier(0)
    Unit cur, nxt; int ui = 0;
    if (!S.next(0, cur)) return;
    f32x4 acc[2][2][4][2];
#pragma unroll
    for (int a = 0; a < 2; ++a)
#pragma unroll
        for (int b = 0; b < 2; ++b)
#pragma unroll
            for (int m = 0; m < 4; ++m)
#pragma unroll
                for (int n = 0; n < 2; ++n) acc[a][b][m][n] = (f32x4){0.f, 0.f, 0.f, 0.f};
    bf16x8 At[4][2], B0[2][2], B1[2][2];
    const char* cA = (const char*)g.A + (size_t)cur.pm * tstep; const char* cB = (const char*)g.Bt + (size_t)cur.pn * tstep;
    S.a_ready(cur);
    if constexpr (SP2) {
        PG8_STAGE(PG8_SB(0, 0), cB, voffB); PG8_STAGE(PG8_SB(0, 1), cB + hstep, voffB); PG8_STAGE(PG8_SA(0, 0), cA, voffA); PG8_STAGE(PG8_SA(0, 1), cA + hstep, voffA);
        if (wr == 1) PG8_BAR;
        PG8_WAIT_V(2); PG8_BAR;
        PG8_STAGE(PG8_SB(1, 0), cB + kstep, voffB); PG8_STAGE(PG8_SA(1, 0), cA + kstep, voffA); PG8_STAGE(PG8_SB(1, 1), cB + hstep + kstep, voffB);
        PG8_WAIT_V(6); PG8_BAR;
    } else {
        PG8_STAGE(PG8_SB(0, 0), cB, voffB); PG8_STAGE(PG8_SA(0, 0), cA, voffA); PG8_STAGE(PG8_SB(0, 1), cB + hstep, voffB); PG8_STAGE(PG8_SA(0, 1), cA + hstep, voffA);
        if (wr == 1) PG8_BAR;
        PG8_WAIT_V(4); PG8_BAR;
        PG8_STAGE(PG8_SB(1, 0), cB + kstep, voffB); PG8_STAGE(PG8_SA(1, 0), cA + kstep, voffA); PG8_STAGE(PG8_SB(1, 1), cB + hstep + kstep, voffB);
        PG8_WAIT_V(6); PG8_BAR;
    }
    for (;;) {
        const bool has_next = S.next(ui + 1, nxt);
        const char* nA = has_next ? (const char*)g.A + (size_t)nxt.pm * tstep : cA; const char* nB = has_next ? (const char*)g.Bt + (size_t)nxt.pn * tstep : cB;
        for (int t = 0; t < nt; t += 2) {
            if constexpr (Epi::MIDSCALE) { if (t == nt / 2) E.mid(acc, cur, wr, fr); }
            const bool last = (t == nt - 2);
            const char* a1 = cA + (size_t)(t + 1) * kstep;
            const char* a2 = last ? nA : cA + (size_t)(t + 2) * kstep; const char* b2 = last ? nB : cB + (size_t)(t + 2) * kstep;
            const char* a3 = a2 + kstep; const char* b3 = b2 + kstep;
            if (last && has_next) S.a_ready(nxt);
            if constexpr (SP2) {
            PG8_LDB(B0, 0, 0); PG8_LDB(B1, 0, 1); PG8_SCHED; PG8_LDA(At, 0, 0); PG8_STAGE(PG8_SA(1, 1), a1 + hstep, voffA);
            PG8_WAIT_V(8); PG8_WAIT_L(0); PG8_BAR; PG8_MMA(0, 0, At, B0); PG8_MMA(0, 1, At, B1); PG8_BAR; PG8_SCHED;
            PG8_LDA(At, 0, 1); PG8_STAGE(PG8_SB(0, 0), b2, voffB); PG8_STAGE(PG8_SB(0, 1), b2 + hstep, voffB); PG8_STAGE(PG8_SA(0, 0), a2, voffA);
            PG8_WAIT_V(8); PG8_WAIT_L(0); PG8_BAR; PG8_MMA(1, 0, At, B0); PG8_MMA(1, 1, At, B1); PG8_BAR; PG8_SCHED;
            PG8_LDB(B0, 1, 0); PG8_LDB(B1, 1, 1); PG8_SCHED; PG8_LDA(At, 1, 0); PG8_STAGE(PG8_SA(0, 1), a2 + hstep, voffA);
            PG8_WAIT_V(8); PG8_WAIT_L(0); PG8_BAR; PG8_MMA(0, 0, At, B0); PG8_MMA(0, 1, At, B1); PG8_BAR; PG8_SCHED;
            PG8_LDA(At, 1, 1); PG8_STAGE(PG8_SB(1, 0), b3, voffB); PG8_STAGE(PG8_SB(1, 1), b3 + hstep, voffB); PG8_STAGE(PG8_SA(1, 0), a3, voffA);
            PG8_WAIT_V(8); PG8_WAIT_L(0); PG8_BAR; PG8_MMA(1, 0, At, B0); PG8_MMA(1, 1, At, B1); PG8_BAR; PG8_SCHED;
            } else {
            PG8_LDB(B0, 0, 0); PG8_SCHED; PG8_LDA(At, 0, 0); PG8_STAGE(PG8_SA(1, 1), a1 + hstep, voffA);
            PG8_WAIT_L(8); PG8_BAR; PG8_WAIT_L(0); PG8_MMA(0, 0, At, B0); PG8_BAR; PG8_SCHED;
            PG8_LDB(B1, 0, 1); PG8_STAGE(PG8_SB(0, 0), b2, voffB);
            PG8_BAR; PG8_WAIT_L(0); PG8_MMA(0, 1, At, B1); PG8_BAR;
            PG8_LDA(At, 0, 1); PG8_STAGE(PG8_SA(0, 0), a2, voffA);
            PG8_BAR; PG8_WAIT_L(0); PG8_MMA(1, 0, At, B0); PG8_BAR; PG8_SCHED;
            PG8_STAGE(PG8_SB(0, 1), b2 + hstep, voffB);
            PG8_WAIT_V(6); PG8_BAR; PG8_MMA(1, 1, At, B1); PG8_BAR;
            PG8_LDB(B0, 1, 0); PG8_SCHED; PG8_LDA(At, 1, 0); PG8_STAGE(PG8_SA(0, 1), a2 + hstep, voffA);
            PG8_WAIT_L(8); PG8_BAR; PG8_WAIT_L(0); PG8_MMA(0, 0, At, B0); PG8_BAR; PG8_SCHED;
            PG8_LDB(B1, 1, 1); PG8_STAGE(PG8_SB(1, 0), b3, voffB);
            PG8_BAR; PG8_WAIT_L(0); PG8_MMA(0, 1, At, B1); PG8_BAR;
            PG8_LDA(At, 1, 1); PG8_STAGE(PG8_SA(1, 0), a3, voffA);
            PG8_BAR; PG8_WAIT_L(0); PG8_MMA(1, 0, At, B0); PG8_BAR; PG8_SCHED;
            PG8_STAGE(PG8_SB(1, 1), b3 + hstep, voffB);
            PG8_WAIT_V(6); PG8_BAR; PG8_MMA(1, 1, At, B1); PG8_BAR;
            }
        }
        if constexpr (ALIGN_EPI) { if (wr == 0) PG8_BAR; }
        if constexpr (!Epi::AFTER_DRAIN) { E(acc, cur, wr, wc, fr, fq); S.done(cur); }
        if (!has_next) break;
#pragma unroll
        for (int a = 0; a < 2; ++a)
#pragma unroll
            for (int b = 0; b < 2; ++b)
#pragma unroll
                for (int m = 0; m < 4; ++m)
#pragma unroll
                    for (int n = 0; n < 2; ++n) acc[a][b][m][n] = (f32x4){0.f, 0.f, 0.f, 0.f};
        cur = nxt; cA = nA; cB = nB; ++ui;
        if constexpr (ALIGN_EPI) { if (wr == 1) PG8_BAR; }
    }
    PG8_WAIT_V(0);
    if constexpr (!ALIGN_EPI) { if (wr == 0) PG8_BAR; }
    PG8_BAR;
    if constexpr (Epi::AFTER_DRAIN) { E.fused(acc, cur, wr, wc, fr, fq, lds, wid, lane); S.done(cur); }
#undef PG8_SA
#undef PG8_SB
#undef PG8_STAGE
#undef PG8_LDA
#undef PG8_LDB
#undef PG8_MMA
#undef PG8_WAIT_V
#undef PG8_WAIT_L
#undef PG8_BAR
#undef PG8_SCHED
}
}
#define PG8_SP2 true
#define PG8_ALIGN true
namespace attn_body {
using bf16=__hip_bfloat16;
using bf16x8=__attribute__((ext_vector_type(8)))short;
using s16x4=__attribute__((ext_vector_type(4)))short;
using f32x16=__attribute__((ext_vector_type(16)))float;
using u32x4=__attribute__((ext_vector_type(4)))unsigned;
using f32x4v=__attribute__((ext_vector_type(4)))float;
constexpr int BATCH=32,NHEAD=8,SEQ=2048,D=64,DM=NHEAD*D;
constexpr int NW=8,QBLK=32,QB=QBLK*NW,KVBLK=64,NQB=SEQ/QB;
constexpr int ATTN_PITCH=DM, ATTN_UNIT_ROWS=QB;
__device__ __forceinline__ int crow(int r,int hi){return (r&3)+8*(r>>2)+4*hi;}
#define SBAR() __builtin_amdgcn_sched_barrier(0)
__device__ __forceinline__ void cmask(f32x16&p0,f32x16&p1,int jb,int qrel,int hi){
  const float NEG=-INFINITY; int kb=64*jb+4*hi;
  #pragma unroll
  for(int r=0;r<16;++r){int kv=kb+(r&3)+8*(r>>2); if(kv>qrel)p0[r]=NEG; if(kv+32>qrel)p1[r]=NEG;}
}

constexpr int NSLOT=3, SLOTB=8192;
constexpr int LDS_K=0, LDS_V=NSLOT*SLOTB, LDS_WS=2*NSLOT*SLOTB, LDS_OST=LDS_WS+NW*64*4, LDS_BYTES=LDS_OST+NW*4096;
constexpr float C2=0.125f*1.4426950408889634f;
__device__ __forceinline__ void glds16(const void*gsrc,unsigned lds_dst){unsigned keep;
  asm volatile("s_mov_b32 %0, m0\n\ts_mov_b32 m0, %2\n\ts_nop 0\n\tglobal_load_lds_dwordx4 %1, off\n\ts_mov_b32 m0, %0":"=&s"(keep):"v"(gsrc),"s"(lds_dst):"memory");}
__device__ __forceinline__ float max3f(float a,float b,float c){float r;asm("v_max3_f32 %0, %1, %2, %3":"=v"(r):"v"(a),"v"(b),"v"(c));return r;}
__device__ __forceinline__ float max2f(float a,float b){float r;asm("v_max_f32_e32 %0, %1, %2":"=v"(r):"v"(a),"v"(b));return r;}
__device__ __forceinline__ float fadd_s(float a,float b){float r;asm("v_add_f32_e32 %0, %1, %2":"=v"(r):"v"(a),"v"(b));return r;}
__device__ __forceinline__ float fsub_s(float a,float b){float r;asm("v_sub_f32_e32 %0, %1, %2":"=v"(r):"v"(a),"v"(b));return r;}
typedef float f32x2_t __attribute__((ext_vector_type(2))); typedef __bf16 bf16x2_t __attribute__((ext_vector_type(2)));
__device__ __forceinline__ unsigned cvtpk_s(float lo,float hi){f32x2_t v={lo,hi};bf16x2_t b=__builtin_convertvector(v,bf16x2_t);return __builtin_bit_cast(unsigned,b);}
#define WAIT_BAR(N) asm volatile("s_waitcnt vmcnt(" #N ") lgkmcnt(0)\n\ts_barrier":::"memory")

__device__ __forceinline__ void qkt(f32x16&p0,f32x16&p1,const char*Kslot,const bf16x8*qr,const f32x16&negm,int r32,int hi){
  const char*kb=Kslot+hi*1024+r32*16;
  #pragma unroll
  for(int d0=0;d0<4;++d0){
    const bf16x8 b0=*reinterpret_cast<const bf16x8*>(kb+d0*2048);
    const bf16x8 b1=*reinterpret_cast<const bf16x8*>(kb+d0*2048+512);
    if(d0==0){p0=__builtin_amdgcn_mfma_f32_32x32x16_bf16(b0,qr[0],negm,0,0,0);p1=__builtin_amdgcn_mfma_f32_32x32x16_bf16(b1,qr[0],negm,0,0,0);}
    else{p0=__builtin_amdgcn_mfma_f32_32x32x16_bf16(b0,qr[d0],p0,0,0,0);p1=__builtin_amdgcn_mfma_f32_32x32x16_bf16(b1,qr[d0],p1,0,0,0);}}
}
typedef __attribute__((address_space(3))) const char* lds_cptr;
typedef short v4i16_t __attribute__((ext_vector_type(4)));
__device__ __forceinline__ void kload8(bf16x8*kf,lds_cptr kp){
  kf[0]=*(const __attribute__((address_space(3))) bf16x8*)(kp);      kf[1]=*(const __attribute__((address_space(3))) bf16x8*)(kp+512);
  kf[2]=*(const __attribute__((address_space(3))) bf16x8*)(kp+2048); kf[3]=*(const __attribute__((address_space(3))) bf16x8*)(kp+2560);
  kf[4]=*(const __attribute__((address_space(3))) bf16x8*)(kp+4096); kf[5]=*(const __attribute__((address_space(3))) bf16x8*)(kp+4608);
  kf[6]=*(const __attribute__((address_space(3))) bf16x8*)(kp+6144); kf[7]=*(const __attribute__((address_space(3))) bf16x8*)(kp+6656);
}
__device__ __forceinline__ void kload2(bf16x8*kf,lds_cptr kp,int j){ kf[2*j]=*(const __attribute__((address_space(3))) bf16x8*)(kp+j*2048); kf[2*j+1]=*(const __attribute__((address_space(3))) bf16x8*)(kp+j*2048+512); }
__device__ __forceinline__ s16x4 vtr(lds_cptr p){ return __builtin_bit_cast(s16x4,__builtin_amdgcn_ds_read_tr16_b64_v4i16((__attribute__((address_space(3))) v4i16_t*)p)); }
__device__ __forceinline__ float rowmax(const f32x16&p0,const f32x16&p1){
  float a=max3f(p0[0],p0[1],p1[0]),b=max3f(p0[2],p0[3],p1[1]);a=max3f(a,p1[2],p1[3]);
  #pragma unroll
  for(int r=4;r<16;r+=4){a=max3f(a,p0[r],p0[r+1]);b=max3f(b,p0[r+2],p0[r+3]);a=max3f(a,p1[r],p1[r+1]);b=max3f(b,p1[r+2],p1[r+3]);}
  const float m=max2f(a,b);
  auto rr=__builtin_amdgcn_permlane32_swap(__float_as_uint(m),__float_as_uint(m),false,false);
  return max2f(__uint_as_float(rr[0]),__uint_as_float(rr[1]));
}
__device__ __forceinline__ void pv(f32x16*o,int vb,bf16x8 pa0,bf16x8 pa1,bf16x8 pa2,bf16x8 pa3){
  #pragma unroll
  for(int d0=0;d0<2;++d0){s16x4 lo[4],hi[4];
    #pragma unroll
    for(int ks=0;ks<4;++ks){
      asm volatile("ds_read_b64_tr_b16 %0,%1 offset:%c2":"=&v"(lo[ks]):"v"(vb),"i"(d0*4096+ks*1024):"memory");
      asm volatile("ds_read_b64_tr_b16 %0,%1 offset:%c2":"=&v"(hi[ks]):"v"(vb),"i"(d0*4096+ks*1024+512):"memory");}
    asm volatile("s_waitcnt lgkmcnt(0)":::"memory");SBAR();
    #define PK(k) (bf16x8){lo[k][0],lo[k][1],lo[k][2],lo[k][3],hi[k][0],hi[k][1],hi[k][2],hi[k][3]}
    o[d0]=__builtin_amdgcn_mfma_f32_32x32x16_bf16(pa0,PK(0),o[d0],0,0,0);
    o[d0]=__builtin_amdgcn_mfma_f32_32x32x16_bf16(pa1,PK(1),o[d0],0,0,0);
    o[d0]=__builtin_amdgcn_mfma_f32_32x32x16_bf16(pa2,PK(2),o[d0],0,0,0);
    o[d0]=__builtin_amdgcn_mfma_f32_32x32x16_bf16(pa3,PK(3),o[d0],0,0,0);
    #undef PK
  }
}

#ifndef ATTN_STORE16
#define ATTN_STORE16(p,v) (*(u32x4*)(p)=(v))
#endif
__device__ __forceinline__ float bf2f(short v){return __uint_as_float(((unsigned)(unsigned short)v)<<16);}
template<int THRL> __device__ __forceinline__ void attn_unit(int b,int h,int qb,const bf16*Q,const bf16*__restrict__ K,const bf16*__restrict__ V,const bf16*__restrict__ G,bf16*Y,float*ssA,const float*__restrict__ kms,char*shm){
  int tid_l=threadIdx.x; asm volatile("":"+v"(tid_l));
  const int tid=tid_l,lane=tid&63,r32=lane&31,hi=lane>>5; const int wid=__builtin_amdgcn_readfirstlane(tid>>6);
  const long rowbase=(long)b*SEQ; const int q0=qb*QB;
  const bf16*Qw=Q+(rowbase+q0+wid*QBLK)*DM+h*D;
  const bf16*Kh=K+rowbase*DM+h*D,*Vh=V+rowbase*DM+h*D;
  const unsigned lds0=(unsigned)(uintptr_t)shm;
  float*wsf=(float*)(shm+LDS_WS)+wid*64;
  const bf16*ksrc=Kh+(long)lane*DM+wid*8;
  const bf16*vsrc=Vh+(long)(16*(wid&3)+(lane>>2))*DM+(wid>>2)*32+(lane&3)*8;
  const unsigned kdst=lds0+LDS_K+wid*1024, vdst=lds0+LDS_V+wid*1024;
  #define PHYS(t) (((t)<4)?(4*qb+(t)):((t)-4))
  #define DMA_K(t,slot) glds16(ksrc+(long)PHYS(t)*KVBLK*DM,(unsigned)__builtin_amdgcn_readfirstlane(kdst+(slot)))
  #define DMA_V(t,slot) glds16(vsrc+(long)PHYS(t)*KVBLK*DM,(unsigned)__builtin_amdgcn_readfirstlane(vdst+(slot)))
  const int vb0=(int)(lds0+LDS_V)+((lane>>4)&1)*32+(lane&3)*8+(4*hi+((lane&15)>>2))*64;
  const char*Kbase=shm+LDS_K; bf16x8 kf[8];
  const lds_cptr shm3=(lds_cptr)shm; const lds_cptr kp0=shm3+LDS_K+hi*1024+r32*16; const lds_cptr vp0=shm3+LDS_V+((lane>>4)&1)*32+(lane&3)*8+(4*hi+((lane&15)>>2))*64;
  const int NT=(q0+QB)/KVBLK;
  DMA_K(0,0);DMA_V(0,0);DMA_K(1,SLOTB);
  bf16x8 qr[4];
  #pragma unroll
  for(int d0=0;d0<4;++d0)qr[d0]=*reinterpret_cast<const bf16x8*>(&Qw[(long)r32*DM+d0*16+hi*8]);
  float mhat=0.f,l_reg=0.f;f32x16 o[2];o[0]=f32x16{};o[1]=f32x16{};f32x16 negm; { float z0_; asm volatile("v_mov_b32 %0, 0":"=v"(z0_)); _Pragma("unroll") for(int r=0;r<16;++r)negm[r]=z0_; } asm volatile("":"+v"(negm));
  const int qrel=wid*QBLK+r32;
  #define CMASK(P0,P1,t) do{ if((t)<4)cmask(P0,P1,(t),qrel,hi);}while(0)
  bool resc=false;
  #define START(P0,P1) do{ const float rm=rowmax(P0,P1); resc=false; \
    { const float dl=rm; mhat=fadd_s(mhat,dl); \
      _Pragma("unroll") for(int r=0;r<16;++r){P0[r]=fsub_s(P0[r],dl);P1[r]=fsub_s(P1[r],dl);} \
      _Pragma("unroll") for(int r=0;r<16;++r)negm[r]=-mhat; asm volatile("":"+v"(negm)); } \
    _Pragma("unroll") for(int r=0;r<16;++r)P0[r]=__builtin_amdgcn_exp2f(P0[r]); }while(0)
  #define RESC() do{ if(resc){ asm volatile("s_waitcnt lgkmcnt(0)":::"memory"); \
      _Pragma("unroll") for(int d_=0;d_<2;++d_) _Pragma("unroll") for(int r=0;r<16;++r)o[d_][r]*=wsf[crow(r,hi)]; } }while(0)
  f32x16 pA0,pA1,pB0,pB1;
  int sl_prev=0,sl_cur=0,sl_next=SLOTB;
  #define ROT() do{sl_prev=sl_cur;sl_cur=sl_next;sl_next=(sl_next==(NSLOT-1)*SLOTB)?0:sl_next+SLOTB;}while(0)
  DMA_K(2,2*SLOTB);
  unsigned selbits=0u;
  { float gsc[7]; int hi_s=hi; asm volatile("":"+v"(hi_s));
    #pragma unroll
    for(int n=0;n<7;++n){ float sg=-INFINITY;
      if(n<qb){ const float*kp=kms+((size_t)(b*8+n)*512+h*64+hi_s*8); sg=0.f;
        #pragma unroll
        for(int d0=0;d0<4;++d0){ const f32x4v k0=*(const f32x4v*)(kp+16*d0), k1=*(const f32x4v*)(kp+16*d0+4);
          sg+=bf2f(qr[d0][0])*k0[0]+bf2f(qr[d0][1])*k0[1]+bf2f(qr[d0][2])*k0[2]+bf2f(qr[d0][3])*k0[3]+bf2f(qr[d0][4])*k1[0]+bf2f(qr[d0][5])*k1[1]+bf2f(qr[d0][6])*k1[2]+bf2f(qr[d0][7])*k1[3]; }
        sg+=__shfl_xor(sg,32); }
      gsc[n]=sg; }
    #pragma unroll
    for(int n=0;n<7;++n){ int rank=0;
      #pragma unroll
      for(int m2=0;m2<7;++m2){ if(m2!=n) rank+=((gsc[m2]>gsc[n])||(gsc[m2]==gsc[n]&&m2<n))?1:0; }
      if(n<qb&&rank<3) selbits|=(1u<<n); } }
  WAIT_BAR(3);
  qkt(pA0,pA1,Kbase,qr,negm,r32,hi);asm volatile("s_nop 15\n\ts_nop 7":"+v"(pA0),"+v"(pA1));CMASK(pA0,pA1,0);
  START(pA0,pA1);
  _Pragma("unroll") for(int r=0;r<16;++r)pA1[r]=__builtin_amdgcn_exp2f(pA1[r]);
  WAIT_BAR(0);
  DMA_K(3,0);DMA_V(1,SLOTB);
  ROT();
  kload8(kf,kp0+sl_cur);
  WAIT_BAR(2);
  s16x4 vlo[8],vhi[8]; u32x4 pw0,pw1,pw2,pw3;
  #define PKW(P,B) cvtpk_s(P[B],P[B+1])
  #define PAF(k) __builtin_bit_cast(bf16x8,pw##k)
  #define VFR(i) (bf16x8){vlo[i][0],vlo[i][1],vlo[i][2],vlo[i][3],vhi[i][0],vhi[i][1],vhi[i][2],vhi[i][3]}
  #define PIN(x) asm volatile("":"+v"(x))
  #define MX3(a,b,c) __builtin_fmaxf(__builtin_fmaxf((a),(b)),(c))
  #define GAPA(MF,A0,A1,A2,A3,W0,W1,PW) do{ MF; sacc+=A0; sacc+=A1; sacc+=A2; sacc+=A3; PIN(sacc); W0; W1; PIN(PW); SBAR(); }while(0)
  #define EX(v) __builtin_amdgcn_exp2f(v)
  #define GAPB(MF,X,B) do{ MF; X[B]=EX(X[B]); X[B+1]=EX(X[B+1]); X[B+2]=EX(X[B+2]); X[B+3]=EX(X[B+3]); PIN(X); SBAR(); }while(0)
  #define VRD(i) do{ vlo[i]=vtr(vp_+(((i)>>2)*4096+((i)&3)*1024)); vhi[i]=vtr(vp_+(((i)>>2)*4096+((i)&3)*1024+512)); }while(0)
  #define KRD(G,j) do{ if(G){ kload2(kf,kp0+sl_next,j); SBAR(); } }while(0)
  #define STEP(C0,C1,P0,P1,t,GK,GV,GL) do{ SBAR(); \
    const lds_cptr vp_=vp0+sl_prev; \
    VRD(0); SBAR(); float sacc=(P0[0]+P0[1]); \
    GAPA(C0=__builtin_amdgcn_mfma_f32_32x32x16_bf16(kf[0],qr[0],negm,0,0,0), P0[2],P0[3],P0[4],P0[5],     pw0[0]=PKW(P0,0), pw0[1]=PKW(P0,2), pw0); \
    VRD(4); SBAR(); GAPA(C1=__builtin_amdgcn_mfma_f32_32x32x16_bf16(kf[1],qr[0],negm,0,0,0), P0[6],P0[7],P0[8],P0[9],     pw0[2]=PKW(P0,4), pw0[3]=PKW(P0,6), pw0); \
    VRD(1); SBAR(); GAPA(C0=__builtin_amdgcn_mfma_f32_32x32x16_bf16(kf[2],qr[1],C0,0,0,0),   P0[10],P0[11],P0[12],P0[13], pw1[0]=PKW(P0,8), pw1[1]=PKW(P0,10), pw1); \
    VRD(5); SBAR(); GAPA(C1=__builtin_amdgcn_mfma_f32_32x32x16_bf16(kf[3],qr[1],C1,0,0,0),   P0[14],P0[15],P1[0],P1[1],   pw1[2]=PKW(P0,12),pw1[3]=PKW(P0,14), pw1); \
    VRD(2); SBAR(); GAPA(C0=__builtin_amdgcn_mfma_f32_32x32x16_bf16(kf[4],qr[2],C0,0,0,0),   P1[2],P1[3],P1[4],P1[5],     pw2[0]=PKW(P1,0), pw2[1]=PKW(P1,2), pw2); \
    VRD(6); SBAR(); GAPA(C1=__builtin_amdgcn_mfma_f32_32x32x16_bf16(kf[5],qr[2],C1,0,0,0),   P1[6],P1[7],P1[8],P1[9],     pw2[2]=PKW(P1,4), pw2[3]=PKW(P1,6), pw2); \
    VRD(3); SBAR(); GAPA(C0=__builtin_amdgcn_mfma_f32_32x32x16_bf16(kf[6],qr[3],C0,0,0,0),   P1[10],P1[11],P1[12],P1[13], pw3[0]=PKW(P1,8), pw3[1]=PKW(P1,10), pw3); \
    VRD(7); SBAR(); GAPA(C1=__builtin_amdgcn_mfma_f32_32x32x16_bf16(kf[7],qr[3],C1,0,0,0),   P1[14],P1[15],0.f,0.f,       pw3[2]=PKW(P1,12),pw3[3]=PKW(P1,14), pw3); \
    l_reg+=sacc; \
    if(GK){DMA_K((t)+3,sl_cur);} if(GV){DMA_V((t)+1,sl_next);} \
    CMASK(C0,C1,t); \
    if((t)>=4){ const bool off_=(((selbits>>((((t)-4)>>2)&7))&1u)==0u); _Pragma("unroll") for(int r=0;r<16;++r){C0[r]=off_?-INFINITY:C0[r];C1[r]=off_?-INFINITY:C1[r];} } \
    { float a=MX3(C0[0],C0[1],C1[0]),b=MX3(C0[2],C0[3],C1[1]); a=MX3(a,C1[2],C1[3]); \
      _Pragma("unroll") for(int r=4;r<16;r+=4){a=MX3(a,C0[r],C0[r+1]);b=MX3(b,C0[r+2],C0[r+3]);a=MX3(a,C1[r],C1[r+1]);b=MX3(b,C1[r+2],C1[r+3]);} \
      float rm=__builtin_fmaxf(a,b); { auto rr=__builtin_amdgcn_permlane32_swap(__float_as_uint(rm),__float_as_uint(rm),false,false); rm=__builtin_fmaxf(__uint_as_float(rr[0]),__uint_as_float(rr[1])); } \
      resc=false; \
      if(__builtin_expect(__any(rm>(float)THRL),0)){ const float dl=__builtin_fmaxf(rm,0.f); mhat+=dl; \
        _Pragma("unroll") for(int r=0;r<16;++r){C0[r]-=dl;C1[r]-=dl;} \
        _Pragma("unroll") for(int r=0;r<16;++r)negm[r]=-mhat; asm volatile("":"+v"(negm)); \
        const float f=__builtin_amdgcn_exp2f(-dl); l_reg*=f; if(hi==0)wsf[r32]=f; resc=true; } } \
    SBAR(); \
    GAPB(o[0]=__builtin_amdgcn_mfma_f32_32x32x16_bf16(PAF(0),VFR(0),o[0],0,0,0), C0,0); \
    GAPB(o[1]=__builtin_amdgcn_mfma_f32_32x32x16_bf16(PAF(0),VFR(4),o[1],0,0,0), C0,4); \
    KRD(GL,0); GAPB(o[0]=__builtin_amdgcn_mfma_f32_32x32x16_bf16(PAF(1),VFR(1),o[0],0,0,0), C0,8); \
    KRD(GL,1); GAPB(o[1]=__builtin_amdgcn_mfma_f32_32x32x16_bf16(PAF(1),VFR(5),o[1],0,0,0), C0,12); \
    KRD(GL,2); GAPB(o[0]=__builtin_amdgcn_mfma_f32_32x32x16_bf16(PAF(2),VFR(2),o[0],0,0,0), C1,0); \
    KRD(GL,3); GAPB(o[1]=__builtin_amdgcn_mfma_f32_32x32x16_bf16(PAF(2),VFR(6),o[1],0,0,0), C1,4); \
    GAPB(o[0]=__builtin_amdgcn_mfma_f32_32x32x16_bf16(PAF(3),VFR(3),o[0],0,0,0), C1,8); \
    GAPB(o[1]=__builtin_amdgcn_mfma_f32_32x32x16_bf16(PAF(3),VFR(7),o[1],0,0,0), C1,12); \
    }while(0)
  int t=1;
  #undef CMASK
  #define CMASK(P0,P1,t) do{ if((t)<4)cmask(P0,P1,(t),qrel,hi);}while(0)
  for(;t+5<NT;t+=2){
    STEP(pB0,pB1,pA0,pA1,t,true,true,true);     WAIT_BAR(2); RESC(); ROT();
    STEP(pA0,pA1,pB0,pB1,t+1,true,true,true);   WAIT_BAR(2); RESC(); ROT();
  }
  #undef CMASK
  #define CMASK(P0,P1,t) do{ if((t)<4)cmask(P0,P1,(t),qrel,hi);}while(0)
  #define ENDW(tt) do{ if((tt)+3<NT){WAIT_BAR(2);} else if((tt)+2<NT){WAIT_BAR(1);} else {WAIT_BAR(0);} }while(0)
  for(;t+1<NT;t+=2){
    STEP(pB0,pB1,pA0,pA1,t,(t+3<NT),(t+1<NT),(t+1<NT));       ENDW(t);   RESC(); ROT();
    STEP(pA0,pA1,pB0,pB1,t+1,(t+4<NT),(t+2<NT),(t+2<NT));     ENDW(t+1); RESC(); ROT();
  }
  STEP(pB0,pB1,pA0,pA1,NT-1,false,false,false); RESC();
  { float sacc=pB0[0]+pB0[1]; _Pragma("unroll") for(int r=2;r<16;++r)sacc+=pB0[r]; _Pragma("unroll") for(int r=0;r<16;++r)sacc+=pB1[r]; l_reg+=sacc;
    pw0=(u32x4){PKW(pB0,0),PKW(pB0,2),PKW(pB0,4),PKW(pB0,6)};pw1=(u32x4){PKW(pB0,8),PKW(pB0,10),PKW(pB0,12),PKW(pB0,14)};pw2=(u32x4){PKW(pB1,0),PKW(pB1,2),PKW(pB1,4),PKW(pB1,6)};pw3=(u32x4){PKW(pB1,8),PKW(pB1,10),PKW(pB1,12),PKW(pB1,14)};
    SBAR(); pv(o,vb0+sl_cur,PAF(0),PAF(1),PAF(2),PAF(3)); }
  #undef PKW
  #undef PAF
  #undef VFR
  #undef PIN
  #undef MX3
  #undef GAPA
  #undef GAPB
  #undef EX
  #undef VRD
  #undef KRD
  #undef STEP
  #undef ENDW
  {auto rr=__builtin_amdgcn_permlane32_swap(__float_as_uint(l_reg),__float_as_uint(l_reg),false,false);l_reg=__uint_as_float(rr[0])+__uint_as_float(rr[1]);}
  int hi_e=hi,r32_e=r32; asm volatile("":"+v"(hi_e),"+v"(r32_e));
  if(hi_e==0)wsf[32+r32_e]=l_reg;asm volatile("s_waitcnt lgkmcnt(0)":::"memory");
  float rli[16];
  #pragma unroll
  for(int r=0;r<16;++r)rli[r]=__builtin_amdgcn_rcpf(wsf[32+crow(r,hi_e)]);
  const long grow0=rowbase+q0+wid*QBLK;
  { bf16*stg=(bf16*)(shm+LDS_OST)+wid*2048;
    #pragma unroll
    for(int r=0;r<16;++r){const int orow=crow(r,hi_e);
      #pragma unroll
      for(int d0=0;d0<2;++d0)stg[orow*64+d0*32+r32_e]=__float2bfloat16(o[d0][r]*rli[r]);}
    asm volatile("s_waitcnt lgkmcnt(0)":::"memory");
    #pragma unroll
    for(int i=0;i<4;++i){int lane_e=lane; asm volatile("":"+v"(lane_e)); const int row=i*8+(lane_e>>3),ch=lane_e&7; const bf16x8 v=*(const bf16x8*)(stg+row*64+ch*8); const long grow=grow0+row;
      const bf16x8 gv=*(const bf16x8*)(G+grow*DM+h*D+ch*8); float yv[8]; float ss=0.f;
      #pragma unroll
      for(int e=0;e<8;++e){const float ov=bf2f(v[e]); ss+=ov*ov; yv[e]=ov*bf2f(gv[e]);}
      ss+=__shfl_xor(ss,1); ss+=__shfl_xor(ss,2); ss+=__shfl_xor(ss,4);
      u32x4 w; w.x=cvtpk_s(yv[0],yv[1]); w.y=cvtpk_s(yv[2],yv[3]); w.z=cvtpk_s(yv[4],yv[5]); w.w=cvtpk_s(yv[6],yv[7]);
      ATTN_STORE16(Y+grow*1024+h*D+ch*8,w); if(ch==0)ssA[grow*8+h]=ss; } }
  asm volatile("s_waitcnt lgkmcnt(0)\n\ts_barrier":::"memory");
  #undef DMA_K
  #undef PHYS
  #undef DMA_V
  #undef CMASK
  #undef START
  #undef RESC
  #undef ROT
}
constexpr int ATTN_LDS_BYTES=LDS_BYTES;
struct AttnTensors { const bf16* Q; const bf16* K; const bf16* V; const bf16* G; bf16* Y; float* ssA; const float* kms; };
struct AttnUnit { int bh; int qb; };
struct StaticOrder {
  int vcu;
  __device__ __forceinline__ explicit StaticOrder(int v):vcu(v){}
  __device__ __forceinline__ bool next(int i,AttnUnit&u)const{ if(i>=8)return false; u.bh=vcu; u.qb=7-i; return true; }
  __device__ __forceinline__ void a_ready(const AttnUnit&)const{}
  __device__ __forceinline__ void done(const AttnUnit&)const{}
};
template<class Sched,int THRL=8> __device__ __forceinline__ void attn_phase(char*lds,const AttnTensors&T,const Sched&S){
  AttnUnit u;
  for(int i=0;S.next(i,u);++i){ S.a_ready(u); attn_unit<THRL>(u.bh/NHEAD,u.bh%NHEAD,u.qb,T.Q,T.K,T.V,T.G,T.Y,T.ssA,T.kms,lds); S.done(u); }
}
#undef SBAR
#undef WAIT_BAR
}
#define LAS __attribute__((address_space(3)))
typedef unsigned short bf16;
typedef unsigned v4u __attribute__((ext_vector_type(4)));
typedef float f32x4 __attribute__((ext_vector_type(4)));
typedef short bf16x8 __attribute__((ext_vector_type(8)));
constexpr int NWAVES = 8;
constexpr int NB = 32, SEQL = 2048, DMODEL = 1024, MROWS = NB * SEQL, NIN = 3072, AW = 512;
constexpr float EPSN = 1e-6f;
constexpr size_t MiB = 1u << 20;
constexpr size_t WS_KMS = 0, CTL_ZERO_BYTES = 1 * MiB;
constexpr size_t WS_WIN = 2 * MiB, WS_WOUT = 8 * MiB, WS_MOD = 10 * MiB, WS_ROPE = 11 * MiB, WS_SSA = 12 * MiB, WS_SSL = 14 * MiB, WS_SSX = 16 * MiB;
constexpr size_t WS_XN = 32 * MiB;
constexpr size_t WS_SEC = 160 * MiB, SEC_BYTES = 64 * MiB;
constexpr size_t WS_END = WS_SEC + 6 * SEC_BYTES;
constexpr int RING_BYTES = 131072, LDS_BYTES = 147456;
constexpr size_t WS_BAR = 768 * 1024;

__device__ __forceinline__ unsigned f2bf(float f) { unsigned u = __builtin_bit_cast(unsigned, f); return (u + 0x7fffu + ((u >> 16) & 1u)) >> 16; }
__device__ __forceinline__ unsigned pk2(float lo, float hi) { return f2bf(lo) | (f2bf(hi) << 16); }
__device__ __forceinline__ float bfu2f(unsigned short v) { return __uint_as_float(((unsigned)v) << 16); }
__device__ __forceinline__ float wave_sum(float v) {
#pragma unroll
    for (int o = 1; o < 64; o <<= 1) v += __shfl_xor(v, o);
    return v;
}
__device__ __forceinline__ void p0_transpose_item(const float* W, int K, int N, bf16* WT, bool qkperm, LAS float* scr, int item, int lane) {
    const int nblk = N / 32, kb = item / nblk, nb = item % nblk, k0 = 64 * kb, n0 = 32 * nb;
#pragma unroll 8
    for (int i = 0; i < 32; ++i) { const int kk = 2 * i + (lane >> 5); scr[kk * 33 + (lane & 31)] = W[(size_t)(k0 + kk) * N + n0 + (lane & 31)]; }
    asm volatile("s_waitcnt lgkmcnt(0)" ::: "memory");
    const int c = lane & 7;
#pragma unroll
    for (int j = 0; j < 4; ++j) { const int n = (lane >> 3) + 8 * j; const LAS float* s = scr + (8 * c) * 33 + n;
        v4u o; o.x = pk2(s[0 * 33], s[1 * 33]); o.y = pk2(s[2 * 33], s[3 * 33]); o.z = pk2(s[4 * 33], s[5 * 33]); o.w = pk2(s[6 * 33], s[7 * 33]);
        int nsrc = n0 + n, ndst = nsrc;
        if (qkperm && nsrc < 1024) { const int d = nsrc & 63; ndst = (nsrc & ~63) + 32 * ((d >> 4) & 1) + 8 * ((d >> 2) & 3) + 4 * (d >> 5) + (d & 3); }
        *(v4u*)(WT + (size_t)ndst * K + k0 + 8 * c) = o; }
    asm volatile("s_waitcnt lgkmcnt(0)" ::: "memory");
}

#define XB_TMO      128
#define XB_XCNT(j)  (256  + 64 * (j))
#define XB_XSUB(j)  (1280 + 64 * (j))
#define XB_XGEN(j)  (2304 + 64 * (j))
#define XB_TOP      3328
#define XB_TOPGEN   3392
#define XCD_BAR_WORDS 3456
#define XB_SPIN_CAP (1u << 18)

__device__ __forceinline__ unsigned xb_ld(unsigned* p)              { return __hip_atomic_load(p, __ATOMIC_RELAXED, __HIP_MEMORY_SCOPE_AGENT); }
__device__ __forceinline__ unsigned xb_add(unsigned* p, unsigned v) { return __hip_atomic_fetch_add(p, v, __ATOMIC_RELAXED, __HIP_MEMORY_SCOPE_AGENT); }
__device__ __forceinline__ unsigned xb_xcc_id() { return (unsigned)__builtin_amdgcn_s_getreg((3 << 11) | 20) & 0xFu; }
#define XB_SPIN(cond, bar) do { unsigned _sp = 0; while (cond) { __builtin_amdgcn_s_sleep(1); \
    if ((++_sp & 255u) == 0u) { if (xb_ld(&(bar)[XB_TMO])) break; if (_sp > XB_SPIN_CAP) { atomicAdd(&(bar)[XB_TMO], 1u); break; } } } } while (0)

struct XcdBarrier {
    unsigned* bar; unsigned x;
    volatile LAS unsigned* st;
};

__device__ __forceinline__ XcdBarrier xcd_barrier_post(unsigned* bar, volatile LAS unsigned* st) {
    XcdBarrier b; b.bar = bar; b.x = xb_xcc_id(); b.st = st;
    if (threadIdx.x == 0) (void)xb_add(&bar[XB_XCNT(b.x)], 1u);
    return b;
}
__device__ __forceinline__ void xcd_barrier_complete(unsigned* bar, unsigned x, unsigned& nloc, unsigned& nx) {
    const unsigned G = gridDim.x * gridDim.y * gridDim.z;
    unsigned sum, cnt, mine, sp = 0u;
    for (;;) {
        sum = 0u; cnt = 0u; mine = 0u;
#pragma unroll
        for (unsigned j = 0; j < 16; ++j) { const unsigned c = xb_ld(&bar[XB_XCNT(j)]); sum += c; cnt += (c > 0u) ? 1u : 0u; mine = (j == x) ? c : mine; }
        if (sum == G) break;
        __builtin_amdgcn_s_sleep(1);
        if ((++sp & 255u) == 0u) { if (xb_ld(&bar[XB_TMO])) break; if (sp > XB_SPIN_CAP) { atomicAdd(&bar[XB_TMO], 1u); break; } }
    }
    nloc = mine > 0u ? mine : 1u; nx = cnt > 0u ? cnt : 1u;
}

__device__ __forceinline__ void xcd_barrier(const XcdBarrier& b) {
    asm volatile("s_waitcnt vmcnt(0)" ::: "memory");
    __syncthreads();
    if (threadIdx.x == 0) {
        unsigned* bar = b.bar;
        __builtin_amdgcn_s_waitcnt(0);
        unsigned nloc = b.st[0], nx = b.st[1];
        if (nloc == 0u) { xcd_barrier_complete(bar, b.x, nloc, nx); b.st[0] = nloc; b.st[1] = nx; }
        const unsigned old = xb_add(&bar[XB_XSUB(b.x)], 1u);
        const unsigned gen = old / nloc;
        if (old + 1u == (gen + 1u) * nloc) {
            __builtin_amdgcn_fence(__ATOMIC_RELEASE, "agent");
            asm volatile("s_waitcnt vmcnt(0)" ::: "memory");
            const unsigned og = xb_add(&bar[XB_TOP], 1u);
            const unsigned tg = og / nx;
            if (og + 1u == (tg + 1u) * nx) xb_add(&bar[XB_TOPGEN], 1u);
            else XB_SPIN(xb_ld(&bar[XB_TOPGEN]) == tg, bar);
            __builtin_amdgcn_fence(__ATOMIC_ACQUIRE, "agent");
            xb_add(&bar[XB_XGEN(b.x)], 1u);
            asm volatile("s_waitcnt vmcnt(0)" ::: "memory");
        } else {
            XB_SPIN(xb_ld(&bar[XB_XGEN(b.x)]) == gen, bar);
            __builtin_amdgcn_fence(__ATOMIC_ACQUIRE, "agent");
            asm volatile("s_waitcnt vmcnt(0)" ::: "memory");
        }
    }
    __syncthreads();
}

namespace lru_body {
constexpr int T = 64;
constexpr int XS_OFF = 0, XCF_OFF = 17408, XCB_OFF = XCF_OFF + 16384, A_OFF = XCB_OFF + 9216, U_OFF = A_OFF + 16384, CAR_OFF = U_OFF + 16384, LRU_LDS = CAR_OFF + 4096;
static_assert(LRU_LDS <= RING_BYTES, "lru lds");
__device__ __forceinline__ void lru_unit(LAS unsigned char* lds, int b, int g, const bf16* XL, const bf16* ZL, bf16* Y, float* ssL,
                                         const float* conv_w, const float* conv_b, const float* w_r, const float* b_r, const float* w_i, const float* b_i, const float* lam) {
    int tid_l = threadIdx.x; asm volatile("" : "+v"(tid_l));
    const int tid = tid_l, lane = tid & 63, wid = __builtin_amdgcn_readfirstlane(tid >> 6);
    LAS float* XS = (LAS float*)(lds + XS_OFF); LAS float* XCF = (LAS float*)(lds + XCF_OFF); LAS unsigned short* XCB = (LAS unsigned short*)(lds + XCB_OFF);
    LAS float* AS = (LAS float*)(lds + A_OFF); LAS float* US = (LAS float*)(lds + U_OFF); LAS float* CAR = (LAS float*)(lds + CAR_OFF);
    const int ct = tid >> 3, cc8 = (tid & 7) * 8;
    float cw[4][8], cb[8];
#pragma unroll
    for (int e = 0; e < 8; ++e) { cb[e] = conv_b[g * 64 + cc8 + e];
#pragma unroll
        for (int j = 0; j < 4; ++j) cw[j][e] = conv_w[j * 512 + g * 64 + cc8 + e]; }
    const int fr = lane & 15, fq = lane >> 4, cgp = wid & 3, rh = wid >> 2;
    bf16x8 wrf[2], wif[2];
#pragma unroll
    for (int ks = 0; ks < 2; ++ks)
#pragma unroll
        for (int j = 0; j < 8; ++j) { const size_t wi = ((size_t)g * 64 + 32 * ks + 8 * fq + j) * 64 + 16 * cgp + fr;
            wrf[ks][j] = (short)f2bf(w_r[wi]); wif[ks][j] = (short)f2bf(w_i[wi]); }
    const int ch0 = 16 * cgp + 4 * fq;
    float brr[4], bii[4], spc[4];
#pragma unroll
    for (int r = 0; r < 4; ++r) { brr[r] = b_r[g * 64 + ch0 + r]; bii[r] = b_i[g * 64 + ch0 + r]; spc[r] = -8.0f * log1pf(expf(-lam[g * 64 + ch0 + r])); }
    const int sch = lane, sub = wid;
    float hc = 0.f;
    const size_t rowb = (size_t)b * SEQL;
    const int lr = tid >> 3, lc8 = (tid & 7) * 8;
    v4u px0, px1 = (v4u){0u, 0u, 0u, 0u};
    { const int tok = lr - 3; px0 = (v4u){0u, 0u, 0u, 0u}; if (tok >= 0) px0 = *(const v4u*)(XL + (rowb + tok) * 512 + g * 64 + lc8);
      if (tid < 24) px1 = *(const v4u*)(XL + (rowb + 61 + lr) * 512 + g * 64 + lc8); }
    for (int c = 0; c < SEQL / T; ++c) {
        const int t0 = c * T;
        { LAS float* d = XS + lr * 64 + lc8;
          d[0] = bfu2f(px0.x & 0xffff); d[1] = bfu2f(px0.x >> 16); d[2] = bfu2f(px0.y & 0xffff); d[3] = bfu2f(px0.y >> 16);
          d[4] = bfu2f(px0.z & 0xffff); d[5] = bfu2f(px0.z >> 16); d[6] = bfu2f(px0.w & 0xffff); d[7] = bfu2f(px0.w >> 16);
          if (tid < 24) { LAS float* d2 = XS + (64 + lr) * 64 + lc8;
            d2[0] = bfu2f(px1.x & 0xffff); d2[1] = bfu2f(px1.x >> 16); d2[2] = bfu2f(px1.y & 0xffff); d2[3] = bfu2f(px1.y >> 16);
            d2[4] = bfu2f(px1.z & 0xffff); d2[5] = bfu2f(px1.z >> 16); d2[6] = bfu2f(px1.w & 0xffff); d2[7] = bfu2f(px1.w >> 16); } }
        __syncthreads();
        if (c + 1 < SEQL / T) { const size_t tok = rowb + t0 + T - 3 + lr; px0 = *(const v4u*)(XL + tok * 512 + g * 64 + lc8);
            if (tid < 24) px1 = *(const v4u*)(XL + (tok + 64) * 512 + g * 64 + lc8); }
        const v4u pg = *(const v4u*)(ZL + (rowb + t0 + ct) * 512 + g * 64 + cc8);
        { float xc[8];
#pragma unroll
          for (int e = 0; e < 8; ++e) xc[e] = cb[e];
#pragma unroll
          for (int j = 0; j < 4; ++j) { const f32x4 a0 = *(const LAS f32x4*)(XS + (ct + j) * 64 + cc8), a1 = *(const LAS f32x4*)(XS + (ct + j) * 64 + cc8 + 4);
#pragma unroll
              for (int e = 0; e < 4; ++e) { xc[e] += cw[j][e] * a0[e]; xc[4 + e] += cw[j][4 + e] * a1[e]; } }
          *(LAS f32x4*)(XCF + ct * 64 + cc8) = (f32x4){xc[0], xc[1], xc[2], xc[3]}; *(LAS f32x4*)(XCF + ct * 64 + cc8 + 4) = (f32x4){xc[4], xc[5], xc[6], xc[7]};
          v4u o; o.x = pk2(xc[0], xc[1]); o.y = pk2(xc[2], xc[3]); o.z = pk2(xc[4], xc[5]); o.w = pk2(xc[6], xc[7]);
          *(LAS v4u*)(XCB + ct * 72 + cc8) = o; }
        __syncthreads();
#pragma unroll
        for (int tt = 0; tt < 2; ++tt) {
            const int tok = 32 * rh + 16 * tt + fr;
            f32x4 dr = (f32x4){0.f, 0.f, 0.f, 0.f}, di = (f32x4){0.f, 0.f, 0.f, 0.f};
#pragma unroll
            for (int ks = 0; ks < 2; ++ks) { const bf16x8 xf = *(const LAS bf16x8*)(XCB + tok * 72 + 32 * ks + 8 * fq);
                dr = __builtin_amdgcn_mfma_f32_16x16x32_bf16(wrf[ks], xf, dr, 0, 0, 0); di = __builtin_amdgcn_mfma_f32_16x16x32_bf16(wif[ks], xf, di, 0, 0, 0); }
            const f32x4 xv = *(const LAS f32x4*)(XCF + tok * 64 + ch0);
            f32x4 av, uv;
#pragma unroll
            for (int r = 0; r < 4; ++r) { const float rg = 1.0f / (1.0f + __expf(-(dr[r] + brr[r]))), ig = 1.0f / (1.0f + __expf(-(di[r] + bii[r])));
                const float la = rg * spc[r]; av[r] = __expf(la); uv[r] = sqrtf(-expm1f(2.0f * la)) * ig * xv[r]; }
            *(LAS f32x4*)(AS + tok * 64 + ch0) = av; *(LAS f32x4*)(US + tok * 64 + ch0) = uv;
        }
        __syncthreads();
        float a8[8], u8[8]; float P = 1.f, H = 0.f;
#pragma unroll
        for (int i = 0; i < 8; ++i) { a8[i] = AS[(8 * sub + i) * 64 + sch]; u8[i] = US[(8 * sub + i) * 64 + sch]; H = a8[i] * H + u8[i]; P *= a8[i]; }
        CAR[sub * 64 + sch] = P; CAR[512 + sub * 64 + sch] = H;
        __syncthreads();
        { float h = hc, hin = hc;
#pragma unroll
          for (int s = 0; s < 8; ++s) { const float Ps = CAR[s * 64 + sch], Hs = CAR[512 + s * 64 + sch]; if (s == sub) hin = h; h = Ps * h + Hs; }
          hc = h; h = hin;
#pragma unroll
          for (int i = 0; i < 8; ++i) { h = a8[i] * h + u8[i]; US[(8 * sub + i) * 64 + sch] = h; } }
        __syncthreads();
        { const f32x4 r0 = *(const LAS f32x4*)(US + ct * 64 + cc8), r1 = *(const LAS f32x4*)(US + ct * 64 + cc8 + 4);
          float ss = (r0[0] * r0[0] + r0[1] * r0[1]) + (r0[2] * r0[2] + r0[3] * r0[3]) + (r1[0] * r1[0] + r1[1] * r1[1]) + (r1[2] * r1[2] + r1[3] * r1[3]);
          ss += __shfl_xor(ss, 1); ss += __shfl_xor(ss, 2); ss += __shfl_xor(ss, 4);
          v4u o; o.x = pk2(r0[0] * bfu2f(pg.x & 0xffff), r0[1] * bfu2f(pg.x >> 16)); o.y = pk2(r0[2] * bfu2f(pg.y & 0xffff), r0[3] * bfu2f(pg.y >> 16));
          o.z = pk2(r1[0] * bfu2f(pg.z & 0xffff), r1[1] * bfu2f(pg.z >> 16)); o.w = pk2(r1[2] * bfu2f(pg.w & 0xffff), r1[3] * bfu2f(pg.w >> 16));
          const size_t row = rowb + t0 + ct;
          *(v4u*)(Y + row * 1024 + 512 + g * 64 + cc8) = o;
          if ((tid & 7) == 0) ssL[row * 8 + g] = ss; }
    }
    __syncthreads();
}
}

#ifndef REP_P0
#define REP_P0 1
#endif
#ifndef REP_XN
#define REP_XN 1
#endif
#ifndef REP_P1
#define REP_P1 1
#endif
#ifndef REP_LRU
#define REP_LRU 1
#endif
#ifndef REP_ATT
#define REP_ATT 1
#endif
#ifndef REP_P3
#define REP_P3 1
#endif
struct Args { const float* in[17]; float* out; unsigned char* ws; };
__global__ void __launch_bounds__(NWAVES * 64, 2) hymba_fwd(Args args) {
    extern __shared__ __attribute__((aligned(16))) unsigned char lds_raw[];
    cg::grid_group grid = cg::this_grid();
    LAS unsigned char* lds = (LAS unsigned char*)lds_raw;
    const int tid = threadIdx.x, lane = tid & 63, wave = __builtin_amdgcn_readfirstlane(tid >> 6);
    const int G = gridDim.x, bx = blockIdx.x;
    unsigned char* ws = args.ws;
    const float* x = args.in[0]; const float* cin = args.in[1]; const float* w_mod = args.in[2]; const float* b_mod = args.in[3]; const float* norm_gain = args.in[4];
    const float* w_in = args.in[5]; const float* conv_w = args.in[6]; const float* conv_b = args.in[7]; const float* w_rg = args.in[8]; const float* b_rg = args.in[9];
    const float* w_ig = args.in[10]; const float* b_ig = args.in[11]; const float* lam = args.in[12]; const float* gA = args.in[13]; const float* gL = args.in[14];
    const float* w_out = args.in[15]; const float* final_gain = args.in[16];
    float* out = args.out;
    float* KMS = (float*)(ws + WS_KMS); bf16* WIN = (bf16*)(ws + WS_WIN); bf16* WOUT = (bf16*)(ws + WS_WOUT); float* MOD = (float*)(ws + WS_MOD);
    float* ROPEC = (float*)(ws + WS_ROPE); float* ROPES = ROPEC + 2048 * 32; float* SSA = (float*)(ws + WS_SSA); float* SSL = (float*)(ws + WS_SSL); float* SSX = (float*)(ws + WS_SSX);
    bf16* XN = (bf16*)(ws + WS_XN); bf16* Y = XN; bf16* SEC = (bf16*)(ws + WS_SEC);
    bf16* QB_ = SEC; bf16* KB_ = SEC + 1 * (SEC_BYTES / 2); bf16* VB_ = SEC + 2 * (SEC_BYTES / 2); bf16* ZA_ = SEC + 3 * (SEC_BYTES / 2); bf16* XL_ = SEC + 4 * (SEC_BYTES / 2); bf16* ZL_ = SEC + 5 * (SEC_BYTES / 2);
    const int gw = bx * NWAVES + wave, NGW = G * NWAVES;
    for (int u = tid; u < (LDS_BYTES - RING_BYTES) / 4; u += NWAVES * 64) ((LAS unsigned*)(lds + RING_BYTES))[u] = 0u;
    __syncthreads();
    XcdBarrier bar = xcd_barrier_post((unsigned*)(ws + WS_BAR), (volatile LAS unsigned*)(lds + RING_BYTES + 320) + 8);

    for (int rep_ = 0; rep_ < REP_P0; ++rep_) {
        LAS float* scr = (LAS float*)(lds + wave * 16384);
        constexpr int I_IN = (DMODEL / 64) * (NIN / 32), I_OUT = (DMODEL / 64) * (DMODEL / 32);
        for (int it = gw; it < I_IN + I_OUT; it += NGW) {
            if (it < I_IN) p0_transpose_item(w_in, DMODEL, NIN, WIN, true, scr, it, lane);
            else p0_transpose_item(w_out, DMODEL, DMODEL, WOUT, false, scr, it - I_IN, lane);
        }
        for (int e = bx * 512 + tid; e < 2048 * 32; e += G * 512) {
            const int pos = e >> 5, i = e & 31;
            const float invf = (float)exp2(-(double)(2 * i) / 64.0 * 13.287712379549449);
            const float ang = (float)pos * invf;
            double a = (double)ang; const double n2 = rint(a * 0.15915494309189535); a = (a - n2 * 6.283185307179586) - n2 * 2.4492935982947064e-16;
            double a2 = a * a, sc = 1.0, cc = 1.0, ts = 1.0, tc = 1.0;
            for (int k = 1; k <= 15; ++k) { tc = -tc * a2 / (double)((2 * k - 1) * (2 * k)); ts = -ts * a2 / (double)((2 * k) * (2 * k + 1)); cc += tc; sc += ts; }
            ROPEC[e] = (float)cc; ROPES[e] = (float)(sc * a);
        }
        __syncthreads();
        if (bx < 48) {
            LAS float* cs = (LAS float*)lds;
            for (int idx = tid; idx < 32768; idx += 512) { const int bb = idx >> 10, k = idx & 1023; const float v = cin[idx]; cs[k * 32 + bb] = v / (1.0f + expf(-v)); }
            __syncthreads();
            const int n = bx * 64 + lane;
            float acc[32];
#pragma unroll
            for (int i = 0; i < 32; ++i) acc[i] = 0.f;
            for (int k = wave * 128; k < wave * 128 + 128; ++k) {
                const float w = w_mod[(size_t)k * 3072 + n];
#pragma unroll
                for (int b4 = 0; b4 < 8; ++b4) { const f32x4 cv = *(const LAS f32x4*)(cs + k * 32 + 4 * b4);
                    acc[4 * b4 + 0] += w * cv[0]; acc[4 * b4 + 1] += w * cv[1]; acc[4 * b4 + 2] += w * cv[2]; acc[4 * b4 + 3] += w * cv[3]; }
            }
            __syncthreads();
            LAS float* red = (LAS float*)lds;
#pragma unroll
            for (int i = 0; i < 32; ++i) red[(wave * 32 + i) * 64 + lane] = acc[i];
            __syncthreads();
            for (int o = tid; o < 2048; o += 512) { const int bb = o >> 6, col = o & 63; float s = b_mod[bx * 64 + col];
#pragma unroll
                for (int kg = 0; kg < 8; ++kg) s += red[(kg * 32 + bb) * 64 + col];
                MOD[bb * 3072 + bx * 64 + col] = s; }
            __syncthreads();
        }
    }
    grid.sync();
    for (int rep_ = 0; rep_ < REP_XN; ++rep_)
    for (int gwi = gw; gwi < MROWS / 32; gwi += NGW) {
        const int bb = gwi >> 6;
        f32x4 ca[4], cbv[4];
#pragma unroll
        for (int j = 0; j < 4; ++j) { const int col = 4 * lane + 256 * j; const f32x4 gn = *(const f32x4*)(norm_gain + col), sc = *(const f32x4*)(MOD + bb * 3072 + 1024 + col);
            ca[j] = gn * (sc + 1.0f); cbv[j] = *(const f32x4*)(MOD + bb * 3072 + col); }
        for (int r = 0; r < 32; ++r) {
            const size_t row = (size_t)gwi * 32 + r; const f32x4* xr = (const f32x4*)(x + row * 1024) + lane;
            f32x4 v[4]; float s = 0.f;
#pragma unroll
            for (int j = 0; j < 4; ++j) { v[j] = xr[64 * j]; s += (v[j][0] * v[j][0] + v[j][1] * v[j][1]) + (v[j][2] * v[j][2] + v[j][3] * v[j][3]); }
            const float rinv = 1.0f / sqrtf(wave_sum(s) * (1.0f / 1024.0f) + EPSN);
            unsigned long long* o8 = (unsigned long long*)(XN + row * 1024) + lane;
#pragma unroll
            for (int j = 0; j < 4; ++j) { const f32x4 hh = v[j] * rinv * ca[j] + cbv[j];
                o8[64 * j] = (unsigned long long)pk2(hh[0], hh[1]) | ((unsigned long long)pk2(hh[2], hh[3]) << 32); }
        }
    }
    xcd_barrier(bar);
    for (int rep_ = 0; rep_ < REP_P1; ++rep_) {
        pg8::Gemm g{XN, WIN, MROWS, NIN, DMODEL}; pg8::StaticOrder S; S.init(MROWS, NIN, G, bx);
        pg8::EpiIn E{SEC, SEC_BYTES / 2, ROPEC, ROPES, KMS, gA, gL};
#ifndef SKIP_P1
        pg8::gemm_phase<pg8::EpiIn, pg8::StaticOrder, PG8_ALIGN, PG8_SP2>(lds, g, S, E);
#endif
    }
    xcd_barrier(bar);
    {
        const int vcu = (G % 8 == 0) ? (bx % 8) * (G / 8) + bx / 8 : bx;
        for (int rep_ = 0; rep_ < REP_LRU; ++rep_)
        for (int uu = vcu; uu < 256; uu += G) {
#ifndef SKIP_LRU
            lru_body::lru_unit(lds, uu >> 3, uu & 7, XL_, ZL_, Y, SSL, conv_w, conv_b, w_rg, b_rg, w_ig, b_ig, lam);
#endif
        }
        const attn_body::AttnTensors AT{(const attn_body::bf16*)QB_, (const attn_body::bf16*)KB_, (const attn_body::bf16*)VB_, (const attn_body::bf16*)ZA_, (attn_body::bf16*)Y, SSA, KMS};
        for (int rep_ = 0; rep_ < REP_ATT; ++rep_)
        for (int uu = vcu; uu < 256; uu += G) {
            const attn_body::StaticOrder S(uu);
#ifndef SKIP_ATT
            attn_body::attn_phase<attn_body::StaticOrder>((char*)lds_raw, AT, S);
#endif
        }
    }
    xcd_barrier(bar);
    for (int rep_ = 0; rep_ < REP_P3; ++rep_) {
        pg8::Gemm g{Y, WOUT, MROWS, DMODEL, DMODEL}; pg8::StaticOrder S; S.init(MROWS, DMODEL, G, bx);
        pg8::EpiOut E{x, out, MOD + 2048, SSA, SSL, SSX};
#ifndef SKIP_P3
        pg8::gemm_phase<pg8::EpiOut, pg8::StaticOrder, PG8_ALIGN, PG8_SP2>(lds, g, S, E);
#endif
    }
    xcd_barrier(bar);
    for (int gwi = gw; gwi < MROWS / 32; gwi += NGW) {
        f32x4 fg[4];
#pragma unroll
        for (int j = 0; j < 4; ++j) fg[j] = *(const f32x4*)(final_gain + 4 * lane + 256 * j);
        for (int r = 0; r < 32; ++r) {
            const size_t row = (size_t)gwi * 32 + r; f32x4* xr = (f32x4*)(out + row * 1024) + lane;
            const f32x4* sp = (const f32x4*)(SSX + row * 16); const f32x4 s0 = sp[0], s1 = sp[1], s2 = sp[2], s3 = sp[3];
            const float ss = (((s0[0] + s0[1]) + (s0[2] + s0[3])) + ((s1[0] + s1[1]) + (s1[2] + s1[3]))) + (((s2[0] + s2[1]) + (s2[2] + s2[3])) + ((s3[0] + s3[1]) + (s3[2] + s3[3])));
            const float rinv = 1.0f / sqrtf(ss * (1.0f / 1024.0f) + EPSN);
#pragma unroll
            for (int j = 0; j < 4; ++j) { const f32x4 v = xr[64 * j]; xr[64 * j] = v * rinv * fg[j]; }
        }
    }
}

extern "C" void kernel_launch(void* const* d_in, const int* in_sizes, int n_in, void* d_out, int out_size, void* d_ws, size_t ws_size, hipStream_t stream) {
    static int grid = 0;
    if (grid == 0) {
        if (n_in != 17 || out_size != MROWS * DMODEL || ws_size < WS_END) { fprintf(stderr, "kernel_launch: unexpected shapes (n_in %d out %d ws %zu)\n", n_in, out_size, ws_size); grid = -1; return; }
        int dev = 0, cus = 0, per_cu = 0;
        if (hipGetDevice(&dev) != hipSuccess || hipDeviceGetAttribute(&cus, hipDeviceAttributeMultiprocessorCount, dev) != hipSuccess) { grid = -1; return; }
        if (hipFuncSetAttribute((const void*)hymba_fwd, hipFuncAttributeMaxDynamicSharedMemorySize, LDS_BYTES) != hipSuccess) { fprintf(stderr, "kernel_launch: hipFuncSetAttribute failed\n"); grid = -1; return; }
        if (hipOccupancyMaxActiveBlocksPerMultiprocessor(&per_cu, (const void*)hymba_fwd, NWAVES * 64, LDS_BYTES) != hipSuccess || per_cu < 1) { fprintf(stderr, "kernel_launch: occupancy query says %d\n", per_cu); per_cu = 1; }
        (void)hipGetLastError();
        grid = cus;
        if (grid > 256) grid = 256;
    }
    if (grid < 0) return;
    (void)hipMemsetAsync((char*)d_ws + WS_KMS, 0, CTL_ZERO_BYTES, stream);
    Args a{};
    for (int i = 0; i < 17; ++i) a.in[i] = (const float*)d_in[i];
    a.out = (float*)d_out; a.ws = (unsigned char*)d_ws;
    void* params[] = {&a};
    hipError_t e = hipLaunchCooperativeKernel((const void*)hymba_fwd, dim3(grid), dim3(NWAVES * 64), params, LDS_BYTES, stream);
    if (e != hipSuccess) fprintf(stderr, "kernel_launch: cooperative launch failed: %s (grid %d)\n", hipGetErrorString(e), grid);
}
```
